# Optimizing an MI355X kernel written in HIP

```python
import jax, jax.numpy as jnp
from jax import lax
import numpy as np

D_MODEL = 1024
BATCH = 16
SEQ = 2048
DEPTH = 2

CTX_LEN = 256
GRID_W = 64
RET_HEADS = 8
RET_QK_DIM = 64
RET_V_DIM = 128
RET_QK = RET_HEADS * RET_QK_DIM
RET_V = RET_HEADS * RET_V_DIM
RET_CHUNK = 128
ROPE_BASE = 10000.0
RET_NORM_EPS = 1e-5
RWKV_HEADS = 8
RWKV_HEAD_DIM = 64
RWKV_DIM = RWKV_HEADS * RWKV_HEAD_DIM
DECAY_LORA = 64
AAA_LORA = 64
GATE_LORA = 128
RWKV_NORM_EPS = 64e-5
RWKV_SPLITS = (RWKV_DIM, RWKV_DIM, RWKV_DIM, DECAY_LORA, DECAY_LORA, AAA_LORA, AAA_LORA, GATE_LORA)
RWKV_BLOCK = sum(RWKV_SPLITS)
COL_SPLITS = (RET_QK, RET_QK, RET_V, RET_V, RWKV_BLOCK, D_MODEL, D_MODEL)
W_IN_COLS = sum(COL_SPLITS)
FFN_HIDDEN = -(-8 * D_MODEL // (3 * 256)) * 256
RMS_EPS = 1e-6

kernel_name = 'hybrid_retention_rwkv7_dit_prefix'

F32 = jnp.float32


def split_cols(z, sizes):
    idx, acc = [], 0
    for s in sizes[:-1]:
        acc += s
        idx.append(acc)
    return jnp.split(z, idx, axis=-1)


def split_heads(z, n_heads):
    return z.reshape(*z.shape[:-1], n_heads, z.shape[-1] // n_heads)


def rms_norm(x, g):
    xf = x.astype(F32)
    y = xf * lax.rsqrt(jnp.mean(xf * xf, axis=-1, keepdims=True) + RMS_EPS)
    return (y * g.astype(F32)).astype(x.dtype)


def modulate(h, shift, scale):
    return h * (1 + scale) + shift


def head_norm(y, g, eps):
    yf = y.astype(F32)
    mu = jnp.mean(yf, axis=-1, keepdims=True)
    var = jnp.mean(jnp.square(yf - mu), axis=-1, keepdims=True)
    out = (yf - mu) * lax.rsqrt(var + eps)
    return out.reshape(*y.shape[:-2], -1) * g.astype(F32)


def rope_2d(z):
    n = z.shape[1]
    t = jnp.arange(n)
    row = (t // GRID_W).astype(F32)
    col = (t % GRID_W).astype(F32)
    half = z.shape[-1] // 2
    nfreq = half // 2
    inv = ROPE_BASE ** (-jnp.arange(nfreq, dtype=F32) / nfreq)

    def rot(u, pos):
        ang = pos[:, None] * inv[None, :]
        cos = jnp.cos(ang)[None, :, None, :]
        sin = jnp.sin(ang)[None, :, None, :]
        u1, u2 = u[..., :nfreq], u[..., nfreq:]
        return jnp.concatenate([u1 * cos - u2 * sin, u1 * sin + u2 * cos], axis=-1)

    zf = z.astype(F32)
    return jnp.concatenate([rot(zf[..., :half], row), rot(zf[..., half:], col)], axis=-1)


def qshift_latent(z):
    b, n, ch = z.shape
    rows = n // GRID_W
    g = z.reshape(b, rows, GRID_W, ch // 4, 4)
    gp = jnp.pad(g, ((0, 0), (1, 1), (1, 1), (0, 0), (0, 0)))
    from_left = gp[:, 1:-1, :-2, :, 0]
    from_right = gp[:, 1:-1, 2:, :, 1]
    from_up = gp[:, :-2, 1:-1, :, 2]
    from_down = gp[:, 2:, 1:-1, :, 3]
    return jnp.stack([from_left, from_right, from_up, from_down], axis=-1).reshape(b, n, ch)


def shift_ctx(z):
    b, n, ch = z.shape
    g = z.reshape(b, n, ch // 2, 2)
    gp = jnp.pad(g, ((0, 0), (1, 1), (0, 0), (0, 0)))
    return jnp.stack([gp[:, :-2, :, 0], gp[:, 2:, :, 1]], axis=-1).reshape(b, n, ch)


def retention_chunked(q, k, v, log_gamma, s0, exclusive):
    q, k, v, s0 = q.astype(F32), k.astype(F32), v.astype(F32), s0.astype(F32)
    b, t, h, dk = q.shape
    dv = v.shape[-1]
    n_chunks = t // RET_CHUNK

    def chunks(a):
        return a.reshape(b, n_chunks, RET_CHUNK, h, a.shape[-1]).transpose(1, 0, 2, 3, 4)

    lg = log_gamma.astype(F32)
    pos = jnp.arange(RET_CHUNK, dtype=F32)
    diff = pos[:, None] - pos[None, :]
    mask = diff > 0 if exclusive else diff >= 0
    intra = jnp.where(mask[None], jnp.exp(jnp.maximum(diff, 0.0)[None] * lg[:, None, None]), 0.0)
    q_decay = jnp.exp((pos[:, None] + 1.0) * lg[None, :])
    k_decay = jnp.exp((RET_CHUNK - 1.0 - pos)[:, None] * lg[None, :])
    chunk_decay = jnp.exp(RET_CHUNK * lg)

    def step(s, inp):
        qc, kc, vc = inp
        att = jnp.einsum('bnhd,bmhd->bhnm', qc, kc) * intra[None]
        y = (jnp.einsum('bhnm,bmhe->bnhe', att, vc)
             + jnp.einsum('bnhd,bhde->bnhe', qc, s) * q_decay[None, :, :, None])
        s = s * chunk_decay[None, :, None, None] + jnp.einsum('bmhd,bmhe->bhde', kc * k_decay[None, :, :, None], vc)
        return s, y

    s, y = lax.scan(step, s0, (chunks(q), chunks(k), chunks(v)))
    y = y.transpose(1, 0, 2, 3, 4).reshape(b, t, h, dv)
    return y, s


def retention_bidir(q, k, v, log_gammas, s0_fwd, s0_bwd):
    y_f, s_f = retention_chunked(q, k, v, log_gammas[0], s0_fwd, False)
    y_b, s_b = retention_chunked(q[:, ::-1], k[:, ::-1], v[:, ::-1], log_gammas[1], s0_bwd, True)
    return y_f + y_b[:, ::-1], s_f, s_b


def retention_ctx_states(k, v, log_gammas):
    k, v = k.astype(F32), v.astype(F32)
    n = k.shape[1]
    pos = jnp.arange(n, dtype=F32)
    lg = log_gammas.astype(F32)
    w_f = jnp.exp((n - 1.0 - pos)[:, None] * lg[0][None, :])
    w_b = jnp.exp(pos[:, None] * lg[1][None, :])
    s_f = jnp.einsum('blhd,blhe->bhde', k * w_f[None, :, :, None], v)
    s_b = jnp.einsum('blhd,blhe->bhde', k * w_b[None, :, :, None], v)
    return s_f, s_b


def rwkv7_scan(r, decay, k, v, kk, bvec, s0, exclusive):
    def to_t(z):
        return jnp.moveaxis(z.astype(F32), 1, 0)

    def update(s, w_t, k_t, v_t, kk_t, b_t):
        sk = jnp.einsum('bhvk,bhk->bhv', s, kk_t)
        return s * w_t[:, :, None, :] - sk[..., None] * b_t[:, :, None, :] + v_t[..., None] * k_t[:, :, None, :]

    xs = (to_t(decay), to_t(k), to_t(v), to_t(kk), to_t(bvec))
    s0 = s0.astype(F32)
    if r is None:
        def step_state(s, inp):
            return update(s, *inp), None
        s, _ = lax.scan(step_state, s0, xs)
        return None, s

    def step(s, inp):
        s_new = update(s, *inp[1:])
        y = jnp.einsum('bhvk,bhk->bhv', s if exclusive else s_new, inp[0])
        return s_new, y

    s, y = lax.scan(step, s0, (to_t(r),) + xs)
    return jnp.moveaxis(y, 0, 1), s


def rwkv7_bidir(r, decays, ks, v, kk, bs, s0_fwd, s0_bwd):
    def flip(z):
        return None if z is None else z[:, ::-1]
    y_f, s_f = rwkv7_scan(r, decays[0], ks[0], v, kk, bs[0], s0_fwd, False)
    y_b, s_b = rwkv7_scan(flip(r), flip(decays[1]), flip(ks[1]), flip(v), flip(kk), flip(bs[1]), s0_bwd, True)
    y = None if r is None else y_f + flip(y_b)
    return y, s_f, s_b


def rwkv7_prepare(zb, p):
    zr, zk, zv, zw_f, zw_b, za_f, za_b, zg = split_cols(zb.astype(F32), RWKV_SPLITS)
    kk = split_heads(zk * p['k_k'], RWKV_HEADS)
    kk = kk * lax.rsqrt(jnp.sum(kk * kk, axis=-1, keepdims=True) + 1e-12)
    decays, ks, bs = [], [], []
    for d, (zw, za) in enumerate(((zw_f, za_f), (zw_b, za_b))):
        w_log = -jax.nn.softplus(-(p['w0'][d] + jnp.tanh(zw) @ p['w2'][d])) - 0.5
        decays.append(split_heads(jnp.exp(-jnp.exp(w_log)), RWKV_HEADS))
        a = jax.nn.sigmoid(p['a0'][d] + za @ p['a2'][d])
        ks.append(split_heads(zk * (1 + (a - 1) * p['k_a']), RWKV_HEADS))
        bs.append(kk * split_heads(a, RWKV_HEADS))
    g = jax.nn.sigmoid(zg) @ p['g2']
    return split_heads(zr, RWKV_HEADS), decays, ks, split_heads(zv, RWKV_HEADS), kk, bs, g


def rwkv7_output(y, r, ks, v, g, p):
    k_bonus = 0.5 * (ks[0] + ks[1])
    bonus = jnp.sum(r * k_bonus * p['r_k'][None, None], axis=-1, keepdims=True) * v
    out = head_norm(y, p['rwkv_norm_g'], RWKV_NORM_EPS) + bonus.reshape(*bonus.shape[:-2], -1)
    return out * g


def merge_branches(y_ret, y_rwkv, zga, zgb, p):
    m = (jax.nn.sigmoid(zga.astype(F32)) * (y_ret @ p['w_branch_a'])
         + jax.nn.sigmoid(zgb.astype(F32)) * (y_rwkv @ p['w_branch_b']))
    return m @ p['w_out']


def token_mixer(h_lat, h_ctx, p, ctx_out):
    b = h_lat.shape[0]
    zq, zk, zv, zgr, zrw, zga, zgb = split_cols(h_lat @ p['w_in'], COL_SPLITS)
    cq, ck, cv, cgr, crw, cga, cgb = split_cols(h_ctx @ p['w_in'], COL_SPLITS)
    log_gammas = -jnp.exp(p['ret_decay'].astype(F32))
    k_scale = RET_QK_DIM ** -0.5

    q_c = split_heads(cq, RET_HEADS)
    k_c = split_heads(ck, RET_HEADS) * k_scale
    v_c = split_heads(cv, RET_HEADS)
    zeros_ret = jnp.zeros((b, RET_HEADS, RET_QK_DIM, RET_V_DIM), F32)
    if ctx_out:
        yr_c, sr_f, sr_b = retention_bidir(q_c, k_c, v_c, log_gammas, zeros_ret, zeros_ret)
    else:
        sr_f, sr_b = retention_ctx_states(k_c, v_c, log_gammas)
    q_l = rope_2d(split_heads(zq, RET_HEADS))
    k_l = rope_2d(split_heads(zk, RET_HEADS)) * k_scale
    v_l = split_heads(zv, RET_HEADS)
    yr_l, _, _ = retention_bidir(q_l, k_l, v_l, log_gammas, sr_f, sr_b)
    ret_lat = head_norm(yr_l, p['ret_norm_g'], RET_NORM_EPS) * jax.nn.silu(zgr.astype(F32))

    mu = p['rwkv_mu']
    zb_l = zrw + mu * (qshift_latent(zrw) - zrw)
    zb_c = crw + mu * (shift_ctx(crw) - crw)
    r_c, dec_c, ks_c, v_rc, kk_c, bs_c, g_c = rwkv7_prepare(zb_c, p)
    zeros_rw = jnp.zeros((b, RWKV_HEADS, RWKV_HEAD_DIM, RWKV_HEAD_DIM), F32)
    yw_c, sw_f, sw_b = rwkv7_bidir(r_c if ctx_out else None, dec_c, ks_c, v_rc, kk_c, bs_c, zeros_rw, zeros_rw)
    r_l, dec_l, ks_l, v_rl, kk_l, bs_l, g_l = rwkv7_prepare(zb_l, p)
    yw_l, _, _ = rwkv7_bidir(r_l, dec_l, ks_l, v_rl, kk_l, bs_l, sw_f, sw_b)
    rwkv_lat = rwkv7_output(yw_l, r_l, ks_l, v_rl, g_l, p)

    out_lat = merge_branches(ret_lat, rwkv_lat, zga, zgb, p)
    if not ctx_out:
        return out_lat, None
    ret_ctx = head_norm(yr_c, p['ret_norm_g'], RET_NORM_EPS) * jax.nn.silu(cgr.astype(F32))
    rwkv_ctx = rwkv7_output(yw_c, r_c, ks_c, v_rc, g_c, p)
    out_ctx = merge_branches(ret_ctx, rwkv_ctx, cga, cgb, p)
    return out_lat, out_ctx


def swiglu(h, w13, w2):
    a, g = jnp.split(h @ w13, 2, axis=-1)
    return (jax.nn.silu(a) * g) @ w2


def setup_inputs(seed: int = 0) -> dict:
    key = jax.random.key(seed)
    ks = jax.random.split(key, 32)

    def nrm(k, shape, s):
        return jax.random.normal(k, shape, F32) * s

    L = DEPTH
    hh = jnp.arange(RET_HEADS, dtype=F32)
    theta = jnp.log(-jnp.log1p(-jnp.power(2.0, -5.0 - hh)))
    nn_ = jnp.arange(RWKV_DIM, dtype=F32) / (RWKV_DIM - 1)
    w0_base = -7.0 + 5.0 * nn_ ** 1.35 + 0.5
    return {
        'x': nrm(ks[0], (BATCH, SEQ, D_MODEL), 1.0),
        'c': nrm(ks[1], (BATCH, D_MODEL), 1.0),
        'ctx': nrm(ks[2], (BATCH, CTX_LEN, D_MODEL), 1.0),
        'c_ctx': nrm(ks[3], (D_MODEL,), 1.0),
        'mod_w': nrm(ks[4], (L, D_MODEL, 6 * D_MODEL), 0.5 * D_MODEL ** -0.5),
        'mod_b': nrm(ks[5], (L, 6 * D_MODEL), 0.02),
        'norm1_g': 1.0 + nrm(ks[6], (L, D_MODEL), 0.02),
        'norm2_g': 1.0 + nrm(ks[7], (L, D_MODEL), 0.02),
        'w_in': nrm(ks[8], (L, D_MODEL, W_IN_COLS), D_MODEL ** -0.5),
        'ret_decay': theta[None, None, :] + nrm(ks[9], (L, 2, RET_HEADS), 0.05),
        'ret_norm_g': 1.0 + nrm(ks[10], (L, RET_V), 0.02),
        'rwkv_mu': jax.random.uniform(ks[11], (L, RWKV_BLOCK), F32),
        'rwkv_w0': w0_base[None, None, :] + nrm(ks[12], (L, 2, RWKV_DIM), 0.1),
        'rwkv_w2': nrm(ks[13], (L, 2, DECAY_LORA, RWKV_DIM), 0.1 * DECAY_LORA ** -0.5),
        'rwkv_a0': nrm(ks[14], (L, 2, RWKV_DIM), 0.1),
        'rwkv_a2': nrm(ks[15], (L, 2, AAA_LORA, RWKV_DIM), 0.5 * AAA_LORA ** -0.5),
        'rwkv_g2': nrm(ks[16], (L, GATE_LORA, RWKV_DIM), GATE_LORA ** -0.5),
        'rwkv_k_k': 0.85 + nrm(ks[17], (L, RWKV_DIM), 0.1),
        'rwkv_k_a': 1.0 + nrm(ks[18], (L, RWKV_DIM), 0.1),
        'rwkv_r_k': nrm(ks[19], (L, RWKV_HEADS, RWKV_HEAD_DIM), 0.1),
        'rwkv_norm_g': 1.0 + nrm(ks[20], (L, RWKV_DIM), 0.02),
        'w_branch_a': nrm(ks[21], (L, RET_V, D_MODEL), RET_V ** -0.5),
        'w_branch_b': nrm(ks[22], (L, RWKV_DIM, D_MODEL), RWKV_DIM ** -0.5),
        'w_out': nrm(ks[23], (L, D_MODEL, D_MODEL), D_MODEL ** -0.5),
        'ffn_w13': nrm(ks[24], (L, D_MODEL, 2 * FFN_HIDDEN), D_MODEL ** -0.5),
        'ffn_w2': nrm(ks[25], (L, FFN_HIDDEN, D_MODEL), FFN_HIDDEN ** -0.5),
        'final_norm_g': 1.0 + nrm(ks[26], (D_MODEL,), 0.02),
    }


def reference(x, c, ctx, c_ctx, mod_w, mod_b, norm1_g, norm2_g, w_in, ret_decay, ret_norm_g,
              rwkv_mu, rwkv_w0, rwkv_w2, rwkv_a0, rwkv_a2, rwkv_g2, rwkv_k_k, rwkv_k_a, rwkv_r_k,
              rwkv_norm_g, w_branch_a, w_branch_b, w_out, ffn_w13, ffn_w2, final_norm_g):
    xc = ctx
    for l in range(DEPTH):
        last = l == DEPTH - 1
        p = {
            'w_in': w_in[l], 'ret_decay': ret_decay[l], 'ret_norm_g': ret_norm_g[l],
            'rwkv_mu': rwkv_mu[l], 'w0': rwkv_w0[l], 'w2': rwkv_w2[l], 'a0': rwkv_a0[l], 'a2': rwkv_a2[l],
            'g2': rwkv_g2[l], 'k_k': rwkv_k_k[l], 'k_a': rwkv_k_a[l], 'r_k': rwkv_r_k[l],
            'rwkv_norm_g': rwkv_norm_g[l], 'w_branch_a': w_branch_a[l], 'w_branch_b': w_branch_b[l],
            'w_out': w_out[l],
        }
        sh1, sc1, g1, sh2, sc2, g2 = jnp.split(jax.nn.silu(c) @ mod_w[l] + mod_b[l], 6, axis=-1)
        csh1, csc1, cg1, csh2, csc2, cg2 = jnp.split(jax.nn.silu(c_ctx) @ mod_w[l] + mod_b[l], 6, axis=-1)
        h = modulate(rms_norm(x, norm1_g[l]), sh1[:, None], sc1[:, None])
        hc = modulate(rms_norm(xc, norm1_g[l]), csh1, csc1)
        out, out_c = token_mixer(h, hc, p, not last)
        x = x + (g1[:, None] * out).astype(x.dtype)
        h = modulate(rms_norm(x, norm2_g[l]), sh2[:, None], sc2[:, None])
        x = x + (g2[:, None] * swiglu(h, ffn_w13[l], ffn_w2[l])).astype(x.dtype)
        if not last:
            xc = xc + (cg1 * out_c).astype(xc.dtype)
            hc = modulate(rms_norm(xc, norm2_g[l]), csh2, csc2)
            xc = xc + (cg2 * swiglu(hc, ffn_w13[l], ffn_w2[l])).astype(xc.dtype)
    return rms_norm(x, final_norm_g)
```

```cpp
#include <hip/hip_runtime.h>
#include <hip/hip_cooperative_groups.h>
#include <cstdio>
namespace cg = cooperative_groups;

#ifndef MEGA
#define MEGA 1
#endif

#define DI __device__ __forceinline__
typedef unsigned short u16;
typedef __attribute__((ext_vector_type(8))) short bf16x8;
typedef __attribute__((ext_vector_type(4))) short s16x4;
typedef __attribute__((ext_vector_type(16))) float f32x16;
typedef __attribute__((ext_vector_type(4))) float f32x4;
typedef __attribute__((ext_vector_type(4))) unsigned u32x4;
typedef __attribute__((ext_vector_type(2))) unsigned u32x2;

constexpr int D = 1024, NB = 16, SEQ = 2048, CTX = 256;
constexpr int NL = NB * SEQ, NC = NB * CTX, NT = NL + NC;
constexpr int WIN = 7040, RWB = 1920, FFN = 2816;
constexpr int NIN = 4992;
constexpr int VT_LD = 2304;
constexpr int SMEM_BYTES = 71680;

constexpr size_t WT_IN = 0, WT_A = 7208960, WT_B = 8257536, WT_OUT = 8781824, WT_13 = 9830400, WT_2 = 15597568,
                 WT_G2 = 18481152, WT_TOTAL = 18546688;
constexpr size_t ACTB = (size_t)NT * 1024 * 2;
constexpr size_t OFF_WT = 0;
constexpr size_t OFF_H = WT_TOTAL * 2;
constexpr size_t OFF_QK = OFF_H + ACTB;
constexpr size_t OFF_V = OFF_QK + ACTB;
constexpr size_t OFF_ZGR = OFF_V + ACTB;
constexpr size_t OFF_ZRW = OFF_ZGR + ACTB;
constexpr size_t OFF_CTXRES = OFF_ZRW + (size_t)NT * RWB * 2;
constexpr size_t OFF_MODS = OFF_CTXRES + (size_t)NC * 1024 * 4;
constexpr size_t OFF_BONUS = OFF_MODS + (size_t)2 * 17 * 6144 * 4;
constexpr size_t OFF_TAB = OFF_BONUS + (size_t)NT * 8 * 2 * 4;
constexpr size_t OFF_BAR = OFF_TAB + 8448;
constexpr size_t TAB_BYTES = 8448 + 3456 * 4;
constexpr size_t OFF_RS1 = ((OFF_TAB + TAB_BYTES + 255) / 256) * 256;
constexpr size_t WS_NEED = OFF_RS1 + (size_t)512 * 4 * 16384;

struct Params {
  const float *x, *c, *ctx, *c_ctx, *mod_w, *mod_b, *norm1_g, *norm2_g, *w_in, *ret_decay, *ret_norm_g, *rwkv_mu,
      *rwkv_w0, *rwkv_w2, *rwkv_a0, *rwkv_a2, *rwkv_g2, *rwkv_k_k, *rwkv_k_a, *rwkv_r_k, *rwkv_norm_g, *w_branch_a,
      *w_branch_b, *w_out, *ffn_w13, *ffn_w2, *final_norm_g;
  float* out;
  char* ws;
};

typedef float f32x2_t __attribute__((ext_vector_type(2)));
typedef __bf16 bf16x2_t __attribute__((ext_vector_type(2)));
DI u16 f2bf(float x) { __bf16 r = (__bf16)x; return __builtin_bit_cast(u16, r); }
DI float bf2f(u16 v) { return __uint_as_float(((unsigned)v) << 16); }
DI u32x4 mk4(unsigned a, unsigned b, unsigned c, unsigned d) { u32x4 v; v[0] = a; v[1] = b; v[2] = c; v[3] = d; return v; }
DI u32x2 mk2(unsigned a, unsigned b) { u32x2 v; v[0] = a; v[1] = b; return v; }
DI unsigned pack2(float a, float b) { f32x2_t v = {a, b}; bf16x2_t r = __builtin_convertvector(v, bf16x2_t); return __builtin_bit_cast(unsigned, r); }
DI float frcp(float x) { return __builtin_amdgcn_rcpf(x); }
DI float sigmoidf_(float x) { return frcp(1.f + __expf(-x)); }
DI float siluf_(float x) { return x * frcp(1.f + __expf(-x)); }
DI float tanhf_(float x) { return 1.f - 2.f * frcp(__expf(2.f * x) + 1.f); }
DI float wave_sum(float v) {
#pragma unroll
  for (int m = 32; m >= 1; m >>= 1) v += __shfl_xor(v, m, 64);
  return v;
}
DI float allred16(float x) {
  x += __int_as_float(__builtin_amdgcn_update_dpp(0, __float_as_int(x), 0xB1, 0xF, 0xF, true));
  x += __int_as_float(__builtin_amdgcn_update_dpp(0, __float_as_int(x), 0x4E, 0xF, 0xF, true));
  x += __int_as_float(__builtin_amdgcn_update_dpp(0, __float_as_int(x), 0x141, 0xF, 0xF, true));
  x += __int_as_float(__builtin_amdgcn_update_dpp(0, __float_as_int(x), 0x140, 0xF, 0xF, true));
  return x;
}
DI int ltid() { int t = __builtin_amdgcn_workitem_id_x(); asm volatile("" : "+v"(t)); return t; }
DI int threadIdx_raw() { return __builtin_amdgcn_workitem_id_x(); }
DI int launder(int x) { asm volatile("" : "+v"(x)); return x; }
DI float wave_sum_dpp(float x) {
  x = allred16(x);
  const int xi = __float_as_int(x);
  const float s0 = __int_as_float(__builtin_amdgcn_readlane(xi, 0)), s1 = __int_as_float(__builtin_amdgcn_readlane(xi, 16));
  const float s2 = __int_as_float(__builtin_amdgcn_readlane(xi, 32)), s3 = __int_as_float(__builtin_amdgcn_readlane(xi, 48));
  return (s0 + s1) + (s2 + s3);
}
#define MFMA32(a, b, c) __builtin_amdgcn_mfma_f32_32x32x16_bf16((a), (b), (c), 0, 0, 0)
DI int crow(int reg, int h5) { return (reg & 3) + 8 * (reg >> 2) + 4 * h5; }

DI const float* mods_ptr(const Params& p, int l, int mrow, int chunk) {
  return (const float*)(p.ws + OFF_MODS) + ((size_t)(l * 17 + mrow) * 6144 + chunk * 1024);
}
DI int row_modrow(int row) { return row < NL ? (row >> 11) : 16; }

DI void mods_item(const Params& p, int item, char* smem) {
  const int l = item / 96, cg0 = (item % 96) * 64;
  const int tid = ltid(), lane = tid & 63, wid = tid >> 6;
  float acc[17];
#pragma unroll
  for (int b = 0; b < 17; ++b) acc[b] = 0.f;
  const float* W = p.mod_w + (size_t)l * 1024 * 6144 + cg0 + lane;
  for (int kb = 0; kb < 4; ++kb) {
    const int k0 = wid * 256 + kb * 64;
    float s[17];
#pragma unroll
    for (int b = 0; b < 17; ++b) {
      float cv = (b < 16) ? p.c[b * 1024 + k0 + lane] : p.c_ctx[k0 + lane];
      s[b] = siluf_(cv);
    }
#pragma unroll 8
    for (int kk = 0; kk < 64; ++kk) {
      float wv = W[(size_t)(k0 + kk) * 6144];
#pragma unroll
      for (int b = 0; b < 17; ++b) acc[b] += __shfl(s[b], kk, 64) * wv;
    }
  }
  float* red = (float*)smem;
  __syncthreads();
#pragma unroll
  for (int b = 0; b < 17; ++b) red[(wid * 17 + b) * 64 + lane] = acc[b];
  __syncthreads();
  float* mo = (float*)(p.ws + OFF_MODS);
  for (int e = tid; e < 17 * 64; e += 256) {
    int b = e >> 6, cc = e & 63;
    float v = red[(0 * 17 + b) * 64 + cc] + red[(1 * 17 + b) * 64 + cc] + red[(2 * 17 + b) * 64 + cc] +
              red[(3 * 17 + b) * 64 + cc] + p.mod_b[l * 6144 + cg0 + cc];
    mo[(size_t)(l * 17 + b) * 6144 + cg0 + cc] = v;
  }
  __syncthreads();
}

DI int map_in(int n) {
  if (n < 1024) {
    int p = n & 63, base = n & ~63;
    int d;
    if (p < 32) d = (p < 16) ? p : 32 + (p - 16);
    else { int pp = p - 32; d = (pp < 16) ? 16 + pp : 48 + (pp - 16); }
    return base + d;
  }
  return n;
}
DI int map_13(int n) {
  int q = n >> 6, r = n & 63;
  return (r < 32) ? (q * 32 + r) : (FFN + q * 32 + (r - 32));
}
template <int MAPK>
DI void wconv_tile(const float* __restrict__ W, int K, int Nsrc, u16* __restrict__ Wt, int kt, int nt,
                           char* smem) {
  float* tile = (float*)smem;
  const int tid = ltid();
  const int n = tid & 63;
  const int nd = nt * 64 + n;
  const int src = (MAPK == 1) ? map_in(nd) : (MAPK == 2 ? map_13(nd) : nd);
  __syncthreads();
#pragma unroll
  for (int i = 0; i < 16; ++i) {
    int k = i * 4 + (tid >> 6);
    tile[k * 65 + n] = W[(size_t)(kt * 64 + k) * Nsrc + src];
  }
  __syncthreads();
#pragma unroll
  for (int j = 0; j < 2; ++j) {
    int nn = (tid >> 3) + 32 * j, cch = tid & 7;
    unsigned pk[4];
#pragma unroll
    for (int i = 0; i < 4; ++i) pk[i] = pack2(tile[(cch * 8 + 2 * i) * 65 + nn], tile[(cch * 8 + 2 * i + 1) * 65 + nn]);
    *(u32x4*)(Wt + (size_t)(nt * 64 + nn) * K + kt * 64 + cch * 8) = mk4(pk[0], pk[1], pk[2], pk[3]);
  }
}

constexpr int WC_T_IN = 16 * 110, WC_T_A = 16 * 16, WC_T_B = 8 * 16, WC_T_OUT = 16 * 16, WC_T_13 = 16 * 88,
              WC_T_2 = 44 * 16, WC_T_G2 = 2 * 8;
constexpr int WC_TOTAL = WC_T_IN + WC_T_A + WC_T_B + WC_T_OUT + WC_T_13 + WC_T_2 + WC_T_G2;

DI void wconv_item(const Params& p, int l, int t, char* smem) {
  u16* wt = (u16*)(p.ws + OFF_WT);
  if (t < WC_T_IN) { wconv_tile<1>(p.w_in + (size_t)l * 1024 * WIN, 1024, WIN, wt + WT_IN, t % 16, t / 16, smem); return; }
  t -= WC_T_IN;
  if (t < WC_T_A) { wconv_tile<0>(p.w_branch_a + (size_t)l * 1024 * 1024, 1024, 1024, wt + WT_A, t % 16, t / 16, smem); return; }
  t -= WC_T_A;
  if (t < WC_T_B) { wconv_tile<0>(p.w_branch_b + (size_t)l * 512 * 1024, 512, 1024, wt + WT_B, t % 8, t / 8, smem); return; }
  t -= WC_T_B;
  if (t < WC_T_OUT) { wconv_tile<0>(p.w_out + (size_t)l * 1024 * 1024, 1024, 1024, wt + WT_OUT, t % 16, t / 16, smem); return; }
  t -= WC_T_OUT;
  if (t < WC_T_13) { wconv_tile<2>(p.ffn_w13 + (size_t)l * 1024 * 5632, 1024, 5632, wt + WT_13, t % 16, t / 16, smem); return; }
  t -= WC_T_13;
  if (t < WC_T_2) { wconv_tile<0>(p.ffn_w2 + (size_t)l * FFN * 1024, FFN, 1024, wt + WT_2, t % 44, t / 44, smem); return; }
  t -= WC_T_2;
  wconv_tile<0>(p.rwkv_g2 + (size_t)l * 128 * 512, 128, 512, wt + WT_G2, t % 2, t / 2, smem);
}

DI const float* resid_row(const Params& p, int l, int row) {
  if (row < NL) return (l == 0 ? p.x : p.out) + (size_t)row * 1024;
  return (l == 0 ? p.ctx : (const float*)(p.ws + OFF_CTXRES)) + (size_t)(row - NL) * 1024;
}
DI const float* resid_cur_row(const Params& p, int row) {
  if (row < NL) return p.out + (size_t)row * 1024;
  return (const float*)(p.ws + OFF_CTXRES) + (size_t)(row - NL) * 1024;
}
DI void norm_rows(const Params& p, int l, int which, int nrows, int bid, int nb) {
  const int lane = ltid() & 63, wid = ltid() >> 6;
  const int nw = nb * 4;
  u16* __restrict__ H = (u16*)(p.ws + OFF_H);
  const float* __restrict__ g = (which == 0 ? p.norm1_g : p.norm2_g) + l * 1024;
  const int per = (nrows + nw - 1) / nw;
  const int r0 = (bid * 4 + wid) * per;
  const int r1 = (r0 + per < nrows) ? r0 + per : nrows;
  int cur_mr = -1;
  f32x4 gs[4], shv[4];
#pragma unroll
  for (int i = 0; i < 4; ++i) { gs[i] = 0.f; shv[i] = 0.f; }
  for (int row = r0; row < r1; ++row) {
    const float* __restrict__ src = which == 0 ? resid_row(p, l, row) : resid_cur_row(p, row);
    const int mr = row_modrow(row);
    if (mr != cur_mr) {
      cur_mr = mr;
      const float* __restrict__ sh = mods_ptr(p, l, mr, which == 0 ? 0 : 3);
      const float* __restrict__ sc = mods_ptr(p, l, mr, which == 0 ? 1 : 4);
#pragma unroll
      for (int i = 0; i < 4; ++i) {
        const int k = i * 256 + lane * 4;
        const f32x4 gg = *(const f32x4*)(g + k), s2 = *(const f32x4*)(sc + k);
        shv[i] = *(const f32x4*)(sh + k);
        gs[i][0] = gg[0] * (1.f + s2[0]); gs[i][1] = gg[1] * (1.f + s2[1]);
        gs[i][2] = gg[2] * (1.f + s2[2]); gs[i][3] = gg[3] * (1.f + s2[3]);
      }
    }
    f32x4 v[4];
    float ss = 0.f;
#pragma unroll
    for (int i = 0; i < 4; ++i) {
      v[i] = *(const f32x4*)(src + i * 256 + lane * 4);
      ss += v[i][0] * v[i][0] + v[i][1] * v[i][1] + v[i][2] * v[i][2] + v[i][3] * v[i][3];
    }
    ss = wave_sum_dpp(ss);
    const float rstd = rsqrtf(ss * (1.f / 1024.f) + 1e-6f);
#pragma unroll
    for (int i = 0; i < 4; ++i) {
      const int k = i * 256 + lane * 4;
      const float o0 = v[i][0] * rstd * gs[i][0] + shv[i][0];
      const float o1 = v[i][1] * rstd * gs[i][1] + shv[i][1];
      const float o2 = v[i][2] * rstd * gs[i][2] + shv[i][2];
      const float o3 = v[i][3] * rstd * gs[i][3] + shv[i][3];
      *(u32x2*)(H + (size_t)row * 1024 + k) = mk2(pack2(o0, o1), pack2(o2, o3));
    }
  }
}
DI void final_norm(const Params& p, int bid, int nb) {
  const int lane = ltid() & 63, wid = ltid() >> 6;
  const int nw = nb * 4;
  for (int row = bid * 4 + wid; row < NL; row += nw) {
    float* src = p.out + (size_t)row * 1024;
    f32x4 v[4];
    float ss = 0.f;
#pragma unroll
    for (int i = 0; i < 4; ++i) {
      v[i] = *(const f32x4*)(src + i * 256 + lane * 4);
      ss += v[i][0] * v[i][0] + v[i][1] * v[i][1] + v[i][2] * v[i][2] + v[i][3] * v[i][3];
    }
    ss = wave_sum_dpp(ss);
    const float rstd = rsqrtf(ss * (1.f / 1024.f) + 1e-6f);
#pragma unroll
    for (int i = 0; i < 4; ++i) {
      const int k = i * 256 + lane * 4;
      f32x4 gg = *(const f32x4*)(p.final_norm_g + k);
      f32x4 o;
      o[0] = v[i][0] * rstd * gg[0]; o[1] = v[i][1] * rstd * gg[1]; o[2] = v[i][2] * rstd * gg[2]; o[3] = v[i][3] * rstd * gg[3];
      *(f32x4*)(src + k) = o;
    }
  }
}

DI void gemm_kloop(f32x16 (&acc)[2][2], const u16* __restrict__ A, int lda, const u16* __restrict__ B, int ldb, int K,
                   char* smem) {
  const int tid = ltid(), lane = tid & 63, wid = tid >> 6, wr = wid >> 1, wc = wid & 1;
  const int lr = tid >> 3, lc = tid & 7;
  const int r = lane & 31, h5 = lane >> 5;
  u32x4 ra0[4], rb0[4], ra1[4], rb1[4];
  const int nk = K >> 6;
  const u16* Ap = A + (size_t)lr * lda + lc * 8;
  const u16* Bp = B + (size_t)lr * ldb + lc * 8;
#define GLOAD(RA, RB, kt_) _Pragma("unroll") for (int i = 0; i < 4; ++i) { \
    RA[i] = *(const u32x4*)(Ap + (size_t)(32 * i) * lda + (kt_) * 64); \
    RB[i] = *(const u32x4*)(Bp + (size_t)(32 * i) * ldb + (kt_) * 64); }
#define LSTORE(RA, RB, buf_) _Pragma("unroll") for (int i = 0; i < 4; ++i) { \
    *(u32x4*)(smem + (buf_) * 16384 + woff + i * 4096) = RA[i]; \
    *(u32x4*)(smem + 32768 + (buf_) * 16384 + woff + i * 4096) = RB[i]; }
#define COMPUTE(buf_) __builtin_amdgcn_s_setprio(1); _Pragma("unroll") for (int s = 0; s < 4; ++s) { \
    const int ch = ((2 * s + h5) ^ sw) << 4; \
    bf16x8 a0 = *(const bf16x8*)(smem + (buf_) * 16384 + aoff + ch); \
    bf16x8 a1 = *(const bf16x8*)(smem + (buf_) * 16384 + aoff + 4096 + ch); \
    bf16x8 b0 = *(const bf16x8*)(smem + (buf_) * 16384 + boff + ch); \
    bf16x8 b1 = *(const bf16x8*)(smem + (buf_) * 16384 + boff + 4096 + ch); \
    acc[0][0] = MFMA32(a0, b0, acc[0][0]); \
    acc[0][1] = MFMA32(a0, b1, acc[0][1]); \
    acc[1][0] = MFMA32(a1, b0, acc[1][0]); \
    acc[1][1] = MFMA32(a1, b1, acc[1][1]); } __builtin_amdgcn_s_setprio(0);
  const int woff = lr * 128 + ((lc ^ ((lr >> 1) & 7)) << 4);
  const int sw = (r >> 1) & 7;
  const int aoff = (wr * 64 + r) * 128, boff = 32768 + (wc * 64 + r) * 128;
  GLOAD(ra0, rb0, 0)
  GLOAD(ra1, rb1, 1)
  __syncthreads();
  LSTORE(ra0, rb0, 0)
  __syncthreads();
#pragma unroll 1
  for (int kt = 0; kt < nk; kt += 2) {
    if (kt + 2 < nk) GLOAD(ra0, rb0, kt + 2)
    COMPUTE(0)
    LSTORE(ra1, rb1, 1)
    __syncthreads();
    if (kt + 3 < nk) GLOAD(ra1, rb1, kt + 3)
    COMPUTE(1)
    if (kt + 2 < nk) LSTORE(ra0, rb0, 0)
    __syncthreads();
  }
#undef GLOAD
#undef LSTORE
#undef COMPUTE
}
DI void zero_acc(f32x16 (&acc)[2][2]) {
#pragma unroll
  for (int a = 0; a < 2; ++a)
#pragma unroll
    for (int b = 0; b < 2; ++b)
#pragma unroll
      for (int i = 0; i < 16; ++i) acc[a][b][i] = 0.f;
}


DI void gemm_kloop4(f32x16 (&acc)[4][2], const u16* __restrict__ A, int lda, const u16* __restrict__ B, int ldb, int K,
                    char* smem) {
  const int tid = ltid(), lane = tid & 63, wid = tid >> 6, wr = wid >> 1, wc = wid & 1;
  const int lr = tid >> 3, lc = tid & 7;
  const int r = lane & 31, h5 = lane >> 5;
  u32x4 ra[8], rb[4];
  const int nk = K >> 6;
  const u16* Ap = A + (size_t)lr * lda + lc * 8;
  const u16* Bp = B + (size_t)lr * ldb + lc * 8;
  const int woff = lr * 128 + ((lc ^ ((lr >> 1) & 7)) << 4);
  const int sw = (r >> 1) & 7;
  const int aoff = (wr * 128 + r) * 128, boff = 32768 + (wc * 64 + r) * 128;
#pragma unroll
  for (int i = 0; i < 8; ++i) ra[i] = *(const u32x4*)(Ap + (size_t)(32 * i) * lda);
#pragma unroll
  for (int i = 0; i < 4; ++i) rb[i] = *(const u32x4*)(Bp + (size_t)(32 * i) * ldb);
  __syncthreads();
#pragma unroll
  for (int i = 0; i < 8; ++i) *(u32x4*)(smem + woff + i * 4096) = ra[i];
#pragma unroll
  for (int i = 0; i < 4; ++i) *(u32x4*)(smem + 32768 + woff + i * 4096) = rb[i];
  __syncthreads();
#pragma unroll 1
  for (int kt = 0; kt < nk; ++kt) {
    if (kt + 1 < nk) {
#pragma unroll
      for (int i = 0; i < 8; ++i) ra[i] = *(const u32x4*)(Ap + (size_t)(32 * i) * lda + (kt + 1) * 64);
#pragma unroll
      for (int i = 0; i < 4; ++i) rb[i] = *(const u32x4*)(Bp + (size_t)(32 * i) * ldb + (kt + 1) * 64);
    }
    __builtin_amdgcn_s_setprio(1);
#pragma unroll
    for (int s = 0; s < 4; ++s) {
      const int ch = ((2 * s + h5) ^ sw) << 4;
      const bf16x8 b0 = *(const bf16x8*)(smem + boff + ch);
      const bf16x8 b1 = *(const bf16x8*)(smem + boff + 4096 + ch);
#pragma unroll
      for (int mt = 0; mt < 4; ++mt) {
        const bf16x8 a = *(const bf16x8*)(smem + aoff + mt * 4096 + ch);
        acc[mt][0] = MFMA32(a, b0, acc[mt][0]);
        acc[mt][1] = MFMA32(a, b1, acc[mt][1]);
      }
    }
    __builtin_amdgcn_s_setprio(0);
    __syncthreads();
    if (kt + 1 < nk) {
#pragma unroll
      for (int i = 0; i < 8; ++i) *(u32x4*)(smem + woff + i * 4096) = ra[i];
#pragma unroll
      for (int i = 0; i < 4; ++i) *(u32x4*)(smem + 32768 + woff + i * 4096) = rb[i];
    }
    __syncthreads();
  }
}
template <int MTW> DI void zero_accT(f32x16 (&acc)[MTW][2]) {
#pragma unroll
  for (int a = 0; a < MTW; ++a)
#pragma unroll
    for (int b = 0; b < 2; ++b)
#pragma unroll
      for (int i = 0; i < 16; ++i) acc[a][b][i] = 0.f;
}
DI void kloopT(f32x16 (&acc)[2][2], const u16* A, int lda, const u16* B, int ldb, int K, char* smem) { gemm_kloop(acc, A, lda, B, ldb, K, smem); }
DI void kloopT(f32x16 (&acc)[4][2], const u16* A, int lda, const u16* B, int ldb, int K, char* smem) { gemm_kloop4(acc, A, lda, B, ldb, K, smem); }

template <int MTW> DI void gemm_in_phase(const Params& p, int l, int bid, int nb, char* smem) {
  const u16* H = (const u16*)(p.ws + OFF_H);
  const u16* Wt = (const u16*)(p.ws + OFF_WT) + WT_IN;
  u16* QK = (u16*)(p.ws + OFF_QK);
  u16* VT = (u16*)(p.ws + OFF_V);
  u16* ZGR = (u16*)(p.ws + OFF_ZGR);
  u16* ZRW = (u16*)(p.ws + OFF_ZRW);
  constexpr int NTN = NIN / 128;
  const int ntiles = (NT / (64 * MTW)) * NTN;
#pragma unroll 1
  for (int t = bid; t < ntiles; t += nb) {
    const int mt_ = t / NTN, nt_ = t % NTN;
    const int row0 = mt_ * (64 * MTW), col0 = nt_ * 128;
    if (l == 1 && row0 >= NL && (col0 < 512 || (col0 >= 2048 && col0 < 3072))) continue;
    f32x16 acc[MTW][2];
    zero_accT<MTW>(acc);
    kloopT(acc, H + (size_t)row0 * 1024, 1024, Wt + (size_t)col0 * 1024, 1024, 1024, smem);
    const int lane = launder(ltid() & 63), wid = launder(ltid() >> 6), wr = wid >> 1, wc = wid & 1;
    const int c = lane & 31, h5 = lane >> 5;
    const int wcol = col0 + wc * 64;
    if (col0 < 1024) {
      const bool isk = col0 >= 512;
      const int head = (wcol & 511) >> 6;
      const float scale = isk ? 0.125f : 1.f;
      const int d1 = (c < 16) ? c : 32 + (c - 16);
      const float inv = exp2f(-(float)(c & 15) * (13.287712379549449f / 16.f));
#pragma unroll
      for (int mt = 0; mt < MTW; ++mt) {
#pragma unroll
        for (int i = 0; i < 16; ++i) {
          const int row = row0 + wr * (32 * MTW) + mt * 32 + crow(i, h5);
          float x1 = acc[mt][0][i], x2 = acc[mt][1][i];
          float o1, o2;
          if (row < NL) {
            const int tt = row & 2047;
            const float pos = (float)((c < 16) ? (tt >> 6) : (tt & 63));
            const float ang = pos * inv;
            const float cs = __cosf(ang), sn = __sinf(ang);
            o1 = x1 * cs - x2 * sn;
            o2 = x1 * sn + x2 * cs;
          } else { o1 = x1; o2 = x2; }
          u16* dst = QK + (size_t)row * 1024 + (isk ? 512 : 0) + head * 64;
          dst[d1] = f2bf(o1 * scale);
          dst[d1 + 16] = f2bf(o2 * scale);
        }
      }
    } else if (col0 < 2048) {
#pragma unroll
      for (int mt = 0; mt < MTW; ++mt)
#pragma unroll
        for (int nt = 0; nt < 2; ++nt) {
          const int n = wcol + nt * 32 + c - 1024;
          const int hh = n >> 7, e = n & 127;
#pragma unroll
          for (int q = 0; q < 4; ++q) {
            const int row = row0 + wr * (32 * MTW) + mt * 32 + 8 * q + 4 * h5;
            int b, tcol;
            if (row < NL) { b = row >> 11; tcol = row & 2047; } else { b = (row - NL) >> 8; tcol = 2048 + ((row - NL) & 255); }
            u32x2 pk = mk2(pack2(acc[mt][nt][4 * q], acc[mt][nt][4 * q + 1]), pack2(acc[mt][nt][4 * q + 2], acc[mt][nt][4 * q + 3]));
            *(u32x2*)(VT + ((size_t)((b * 8 + hh) * 128 + e)) * VT_LD + tcol) = pk;
          }
        }
    } else {
      u16* dstb; int ld, cb;
      if (col0 < 3072) { dstb = ZGR; ld = 1024; cb = wcol - 2048; } else { dstb = ZRW; ld = RWB; cb = wcol - 3072; }
#pragma unroll
      for (int mt = 0; mt < MTW; ++mt)
#pragma unroll
        for (int nt = 0; nt < 2; ++nt)
#pragma unroll
          for (int i = 0; i < 16; ++i) {
            const int row = row0 + wr * (32 * MTW) + mt * 32 + crow(i, h5);
            dstb[(size_t)row * ld + cb + nt * 32 + c] = f2bf(acc[mt][nt][i]);
          }
    }
  }
}

DI void gemm_post2_phase(const Params& p, int mrows, int bid, int nb, char* smem) {
  const u16* SG = (const u16*)(p.ws + OFF_V + (size_t)NT * 512 * 2);
  const u16* Wt = (const u16*)(p.ws + OFF_WT) + WT_G2;
  u16* U = (u16*)(p.ws + OFF_V);
  const int ntiles = (mrows / 128) * 4;
#pragma unroll 1
  for (int t = bid; t < ntiles; t += nb) {
    const int row0 = (t >> 2) * 128, col0 = (t & 3) * 128;
    f32x16 acc[2][2];
    zero_acc(acc);
    gemm_kloop(acc, SG + (size_t)row0 * 128, 128, Wt + (size_t)col0 * 128, 128, 128, smem);
    const int lane = launder(ltid() & 63), wid = launder(ltid() >> 6), wr = wid >> 1, wc = wid & 1;
    const int c = lane & 31, h5 = lane >> 5;
    u16* ub = U + (size_t)(row0 + wr * 64 + 4 * h5) * 512 + col0 + wc * 64 + c;
    u16 oldv[2][2][16];
#pragma unroll
    for (int mt = 0; mt < 2; ++mt)
#pragma unroll
      for (int nt = 0; nt < 2; ++nt)
#pragma unroll
        for (int i = 0; i < 16; ++i) oldv[mt][nt][i] = ub[(size_t)(mt * 32 + (i & 3) + 8 * (i >> 2)) * 512 + nt * 32];
#pragma unroll
    for (int mt = 0; mt < 2; ++mt)
#pragma unroll
      for (int nt = 0; nt < 2; ++nt)
#pragma unroll
        for (int i = 0; i < 16; ++i)
          ub[(size_t)(mt * 32 + (i & 3) + 8 * (i >> 2)) * 512 + nt * 32] = f2bf(bf2f(oldv[mt][nt][i]) * acc[mt][nt][i]);
  }
}

DI void gemm_merge_phase(const Params& p, int mrows, int bid, int nb, char* smem) {
  const u16* H = (const u16*)(p.ws + OFF_H);
  const u16* YRET = (const u16*)(p.ws + OFF_ZGR);
  const u16* YRW = (const u16*)(p.ws + OFF_V);
  const u16* WT = (const u16*)(p.ws + OFF_WT);
  u16* M = (u16*)(p.ws + OFF_QK);
  const int ntiles = (mrows / 128) * 8;
#pragma unroll 1
  for (int t = bid; t < ntiles; t += nb) {
    const int row0 = (t >> 3) * 128, col0 = (t & 7) * 128;
    f32x16 a[2][2];
    unsigned sg[2][2][8];
    zero_acc(a);
    gemm_kloop(a, H + (size_t)row0 * 1024, 1024, WT + WT_IN + (size_t)(NIN + col0) * 1024, 1024, 1024, smem);
#pragma unroll
    for (int mt = 0; mt < 2; ++mt)
#pragma unroll
      for (int nt = 0; nt < 2; ++nt)
#pragma unroll
        for (int i = 0; i < 8; ++i) sg[mt][nt][i] = pack2(sigmoidf_(a[mt][nt][2 * i]), sigmoidf_(a[mt][nt][2 * i + 1]));
    zero_acc(a);
    gemm_kloop(a, YRET + (size_t)row0 * 1024, 1024, WT + WT_A + (size_t)col0 * 1024, 1024, 1024, smem);
    {
      const int lane = launder(ltid() & 63), wid = launder(ltid() >> 6), wr = wid >> 1, wc = wid & 1;
      const int c = lane & 31, h5 = lane >> 5;
      u16* mb = M + (size_t)(row0 + wr * 64 + 4 * h5) * 1024 + col0 + wc * 64 + c;
#pragma unroll
      for (int mt = 0; mt < 2; ++mt)
#pragma unroll
        for (int nt = 0; nt < 2; ++nt)
#pragma unroll
          for (int i = 0; i < 16; ++i) {
            const unsigned ps = sg[mt][nt][i >> 1];
            const float sv = bf2f((u16)((i & 1) ? (ps >> 16) : (ps & 0xffffu)));
            mb[(size_t)(mt * 32 + (i & 3) + 8 * (i >> 2)) * 1024 + nt * 32] = f2bf(sv * a[mt][nt][i]);
          }
    }
    zero_acc(a);
    gemm_kloop(a, H + (size_t)row0 * 1024, 1024, WT + WT_IN + (size_t)(NIN + 1024 + col0) * 1024, 1024, 1024, smem);
#pragma unroll
    for (int mt = 0; mt < 2; ++mt)
#pragma unroll
      for (int nt = 0; nt < 2; ++nt)
#pragma unroll
        for (int i = 0; i < 8; ++i) sg[mt][nt][i] = pack2(sigmoidf_(a[mt][nt][2 * i]), sigmoidf_(a[mt][nt][2 * i + 1]));
    zero_acc(a);
    gemm_kloop(a, YRW + (size_t)row0 * 512, 512, WT + WT_B + (size_t)col0 * 512, 512, 512, smem);
    {
      const int lane = launder(ltid() & 63), wid = launder(ltid() >> 6), wr = wid >> 1, wc = wid & 1;
      const int c = lane & 31, h5 = lane >> 5;
      u16* mb = M + (size_t)(row0 + wr * 64 + 4 * h5) * 1024 + col0 + wc * 64 + c;
      u16 oldv[2][2][16];
#pragma unroll
      for (int mt = 0; mt < 2; ++mt)
#pragma unroll
        for (int nt = 0; nt < 2; ++nt)
#pragma unroll
          for (int i = 0; i < 16; ++i) oldv[mt][nt][i] = mb[(size_t)(mt * 32 + (i & 3) + 8 * (i >> 2)) * 1024 + nt * 32];
#pragma unroll
      for (int mt = 0; mt < 2; ++mt)
#pragma unroll
        for (int nt = 0; nt < 2; ++nt)
#pragma unroll
          for (int i = 0; i < 16; ++i) {
            const unsigned ps = sg[mt][nt][i >> 1];
            const float sv = bf2f((u16)((i & 1) ? (ps >> 16) : (ps & 0xffffu)));
            mb[(size_t)(mt * 32 + (i & 3) + 8 * (i >> 2)) * 1024 + nt * 32] = f2bf(bf2f(oldv[mt][nt][i]) + sv * a[mt][nt][i]);
          }
    }
  }
}

template <int MTW> DI void gemm_out_phase(const Params& p, int l, int mrows, int bid, int nb, char* smem) {
  const u16* M = (const u16*)(p.ws + OFF_QK);
  const u16* WT = (const u16*)(p.ws + OFF_WT) + WT_OUT;
  const int ntiles = (mrows / (64 * MTW)) * 8;
#pragma unroll 1
  for (int t = bid; t < ntiles; t += nb) {
    const int row0 = (t >> 3) * (64 * MTW), col0 = (t & 7) * 128;
    f32x16 acc[MTW][2];
    zero_accT<MTW>(acc);
    kloopT(acc, M + (size_t)row0 * 1024, 1024, WT + (size_t)col0 * 1024, 1024, 1024, smem);
    const int lane = launder(ltid() & 63), wid = launder(ltid() >> 6), wr = wid >> 1, wc = wid & 1;
    const int c = lane & 31, h5 = lane >> 5;
    const float* g1 = mods_ptr(p, l, row_modrow(row0), 2);
    {
      const int rb = row0 + wr * (32 * MTW) + 4 * h5;
      const float* srcb = resid_row(p, l, rb) + col0 + wc * 64 + c;
      float* dstb = ((rb < NL) ? p.out + (size_t)rb * 1024 : (float*)(p.ws + OFF_CTXRES) + (size_t)(rb - NL) * 1024) + col0 + wc * 64 + c;
      const float gv0 = g1[col0 + wc * 64 + c], gv1 = g1[col0 + wc * 64 + 32 + c];
#pragma unroll
      for (int mp = 0; mp < MTW; mp += 2) {
        float oldv[2][2][16];
#pragma unroll
        for (int mt = 0; mt < 2; ++mt)
#pragma unroll
          for (int nt = 0; nt < 2; ++nt)
#pragma unroll
            for (int i = 0; i < 16; ++i) oldv[mt][nt][i] = srcb[(size_t)((mp + mt) * 32 + (i & 3) + 8 * (i >> 2)) * 1024 + nt * 32];
#pragma unroll
        for (int mt = 0; mt < 2; ++mt)
#pragma unroll
          for (int nt = 0; nt < 2; ++nt)
#pragma unroll
            for (int i = 0; i < 16; ++i)
              dstb[(size_t)((mp + mt) * 32 + (i & 3) + 8 * (i >> 2)) * 1024 + nt * 32] = oldv[mt][nt][i] + (nt ? gv1 : gv0) * acc[mp + mt][nt][i];
      }
    }
  }
}

template <int MTW> DI void gemm_ffn1_phase(const Params& p, int mrows, int bid, int nb, char* smem) {
  const u16* H = (const u16*)(p.ws + OFF_H);
  const u16* WT = (const u16*)(p.ws + OFF_WT) + WT_13;
  u16* ACT = (u16*)(p.ws + OFF_V);
  const int ntiles = (mrows / (64 * MTW)) * 44;
#pragma unroll 1
  for (int t = bid; t < ntiles; t += nb) {
    const int row0 = (t / 44) * (64 * MTW), col0 = (t % 44) * 128;
    f32x16 acc[MTW][2];
    zero_accT<MTW>(acc);
    kloopT(acc, H + (size_t)row0 * 1024, 1024, WT + (size_t)col0 * 1024, 1024, 1024, smem);
    const int lane = launder(ltid() & 63), wid = launder(ltid() >> 6), wr = wid >> 1, wc = wid & 1;
    const int c = lane & 31, h5 = lane >> 5;
    const int ocol = ((col0 + wc * 64) >> 6) * 32 + c;
#pragma unroll
    for (int mt = 0; mt < MTW; ++mt)
#pragma unroll
      for (int i = 0; i < 16; ++i) {
        const int row = row0 + wr * (32 * MTW) + mt * 32 + crow(i, h5);
        ACT[(size_t)row * FFN + ocol] = f2bf(siluf_(acc[mt][0][i]) * acc[mt][1][i]);
      }
  }
}
template <int MTW> DI void gemm_ffn2_phase(const Params& p, int l, int mrows, int bid, int nb, char* smem) {
  const u16* ACT = (const u16*)(p.ws + OFF_V);
  const u16* WT = (const u16*)(p.ws + OFF_WT) + WT_2;
  const int ntiles = (mrows / (64 * MTW)) * 8;
#pragma unroll 1
  for (int t = bid; t < ntiles; t += nb) {
    const int row0 = (t >> 3) * (64 * MTW), col0 = (t & 7) * 128;
    f32x16 acc[MTW][2];
    zero_accT<MTW>(acc);
    kloopT(acc, ACT + (size_t)row0 * FFN, FFN, WT + (size_t)col0 * FFN, FFN, FFN, smem);
    const int lane = launder(ltid() & 63), wid = launder(ltid() >> 6), wr = wid >> 1, wc = wid & 1;
    const int c = lane & 31, h5 = lane >> 5;
    const float* g2 = mods_ptr(p, l, row_modrow(row0), 5);
    {
      const int rb = row0 + wr * (32 * MTW) + 4 * h5;
      float* dstb = ((rb < NL) ? p.out + (size_t)rb * 1024 : (float*)(p.ws + OFF_CTXRES) + (size_t)(rb - NL) * 1024) + col0 + wc * 64 + c;
      const float gv0 = g2[col0 + wc * 64 + c], gv1 = g2[col0 + wc * 64 + 32 + c];
#pragma unroll
      for (int mp = 0; mp < MTW; mp += 2) {
        float oldv[2][2][16];
#pragma unroll
        for (int mt = 0; mt < 2; ++mt)
#pragma unroll
          for (int nt = 0; nt < 2; ++nt)
#pragma unroll
            for (int i = 0; i < 16; ++i) oldv[mt][nt][i] = dstb[(size_t)((mp + mt) * 32 + (i & 3) + 8 * (i >> 2)) * 1024 + nt * 32];
#pragma unroll
        for (int mt = 0; mt < 2; ++mt)
#pragma unroll
          for (int nt = 0; nt < 2; ++nt)
#pragma unroll
            for (int i = 0; i < 16; ++i)
              dstb[(size_t)((mp + mt) * 32 + (i & 3) + 8 * (i >> 2)) * 1024 + nt * 32] = oldv[mt][nt][i] + (nt ? gv1 : gv0) * acc[mp + mt][nt][i];
      }
    }
  }
}

DI int chunk_row0(int b, int cidx) { return cidx < 16 ? b * 2048 + cidx * 128 : NL + b * 256 + (cidx - 16) * 128; }

DI void build_kt(char* kt, const u16* __restrict__ QK, int row0, int h, float lg2, bool fwd) {
  const int tid = ltid();
#pragma unroll
  for (int j = 0; j < 4; ++j) {
    const int idx = tid + 256 * j;
    const int m = idx >> 3, dc = idx & 7;
    const u32x4 raw = *(const u32x4*)(QK + (size_t)(row0 + m) * 1024 + 512 + h * 64 + dc * 8);
    const float dec = exp2f(lg2 * (float)(fwd ? (127 - m) : m));

#pragma unroll
    for (int i = 0; i < 8; ++i) {
      const u16 e = (u16)((i & 1) ? (raw[i >> 1] >> 16) : (raw[i >> 1] & 0xffffu));
      const int d = dc * 8 + i;
      *(u16*)(kt + d * 256 + ((((m >> 3) ^ (d & 15)) << 4) | ((m & 7) << 1))) = f2bf(bf2f(e) * dec);
    }
  }
}
DI void state_update(f32x16 (&S)[2], const char* kt, const u16* __restrict__ vt_rows  ,
                     float cd, int lane) {
  const int r = lane & 31, h5 = lane >> 5;
#pragma unroll
  for (int i = 0; i < 16; ++i) { S[0][i] *= cd; S[1][i] *= cd; }
#pragma unroll
  for (int s = 0; s < 8; ++s) {
    const bf16x8 bv = *(const bf16x8*)(vt_rows + (size_t)r * VT_LD + s * 16 + h5 * 8);
    const int ch = 2 * s + h5;
    const bf16x8 a0 = *(const bf16x8*)(kt + r * 256 + ((ch ^ (r & 15)) << 4));
    const bf16x8 a1 = *(const bf16x8*)(kt + (32 + r) * 256 + ((ch ^ (r & 15)) << 4));
    S[0] = MFMA32(a0, bv, S[0]);
    S[1] = MFMA32(a1, bv, S[1]);
  }
}

DI void retention_item(const Params& p, int l, bool ctx_out, int item2, char* smem) {
  const int item = item2;
  const int half = item2 & 3, b = item2 >> 5, h = (item2 >> 2) & 7;
  const int tid = ltid();
  int lane = tid & 63, w = tid >> 6, r = lane & 31, h5 = lane >> 5;
  const u16* QK = (const u16*)(p.ws + OFF_QK);
  const u16* VT = (const u16*)(p.ws + OFF_V) + (size_t)((b * 8 + h) * 128) * VT_LD;
  u16* ZGR = (u16*)(p.ws + OFF_ZGR);
  u16* RS = (l == 0) ? (u16*)p.out + (size_t)item * 5 * 8192 : (u16*)(p.ws + OFF_RS1) + (size_t)item * 4 * 8192;
  char* att = smem;
  char* kt = smem + 32768;
  char* stf = smem + 49152;
  const float LOG2E = 1.4426950408889634f;
  const float lgf2 = -__expf(p.ret_decay[(l * 2 + 0) * 8 + h]) * LOG2E;
  const float lgb2 = -__expf(p.ret_decay[(l * 2 + 1) * 8 + h]) * LOG2E;
  const float cdf = __builtin_amdgcn_exp2f(lgf2 * 128.f), cdb = __builtin_amdgcn_exp2f(lgb2 * 128.f);
  f32x16 S[2];
#pragma unroll
  for (int i = 0; i < 16; ++i) { S[0][i] = 0.f; S[1][i] = 0.f; }
#pragma unroll 1
  for (int it = 0; it < 18; ++it) {
    const int cidx = 17 - it;
    if (cidx < 4 * half) break;
    const int row0 = chunk_row0(b, cidx);
    lane = launder(lane); w = launder(w); r = lane & 31; h5 = lane >> 5;
    if ((cidx < 16) ? ((cidx >> 2) == half) : (ctx_out && (cidx - 16) == half)) {
      u16* img = RS + (size_t)((cidx < 16) ? (cidx & 3) : 4) * 8192;
      const int e = w * 32 + r;
#pragma unroll
      for (int dt = 0; dt < 2; ++dt)
#pragma unroll
        for (int q = 0; q < 4; ++q) {
          const int d = dt * 32 + 8 * q + 4 * h5;
          *(u32x2*)(img + e * 64 + d) = mk2(pack2(S[dt][4 * q], S[dt][4 * q + 1]), pack2(S[dt][4 * q + 2], S[dt][4 * q + 3]));
        }
    }
    __syncthreads();
    build_kt(kt, QK, row0, h, lgb2, false);
    __syncthreads();
    state_update(S, kt, VT + (size_t)(w * 32) * VT_LD + cidx * 128, cdb, lane);
  }
  __syncthreads();
#pragma unroll
  for (int i = 0; i < 16; ++i) { S[0][i] = 0.f; S[1][i] = 0.f; }
#pragma unroll 1
  for (int it = 0; it < 18; ++it) {
    const int cidx = it < 2 ? 16 + it : it - 2;
    if (cidx < 16 && cidx > 4 * half + 3) break;
    const int row0 = chunk_row0(b, cidx);
    lane = launder(lane); w = launder(w); r = lane & 31; h5 = lane >> 5;
    const bool mine = (cidx < 16) ? ((cidx >> 2) == half) : ((cidx - 16) == half);
    const bool outp = mine && ((cidx < 16) || ctx_out);
    __syncthreads();
    {
      const int e = w * 32 + r;
#pragma unroll
      for (int dt = 0; dt < 2; ++dt)
#pragma unroll
        for (int q = 0; q < 4; ++q) {
          const int d = dt * 32 + 8 * q + 4 * h5;
          *(u32x2*)(stf + e * 128 + ((((d >> 3) ^ ((e >> 1) & 7)) << 4) | ((d & 7) << 1))) =
              mk2(pack2(S[dt][4 * q], S[dt][4 * q + 1]), pack2(S[dt][4 * q + 2], S[dt][4 * q + 3]));
        }
    }
    build_kt(kt, QK, row0, h, lgf2, true);
    bf16x8 qf[4];
    if (outp) {
      const int n = w * 32 + r;
#pragma unroll
      for (int s = 0; s < 4; ++s) qf[s] = *(const bf16x8*)(QK + (size_t)(row0 + n) * 1024 + h * 64 + s * 16 + h5 * 8);
#pragma unroll
      for (int mt = 0; mt < 4; ++mt) {
        f32x16 a;
#pragma unroll
        for (int i = 0; i < 16; ++i) a[i] = 0.f;
#pragma unroll
        for (int s = 0; s < 4; ++s) {
          const bf16x8 kf = *(const bf16x8*)(QK + (size_t)(row0 + mt * 32 + r) * 1024 + 512 + h * 64 + s * 16 + h5 * 8);
          a = MFMA32(kf, qf[s], a);
        }
#pragma unroll
        for (int q = 0; q < 4; ++q) {
          float o[4];
#pragma unroll
          for (int j = 0; j < 4; ++j) {
            const int m = mt * 32 + 8 * q + 4 * h5 + j;
            const float dd = (m <= n) ? __builtin_amdgcn_exp2f(lgf2 * (float)(n - m)) : __builtin_amdgcn_exp2f(lgb2 * (float)(m - n));
            o[j] = a[4 * q + j] * dd;
          }
          const int m0 = mt * 32 + 8 * q + 4 * h5;
          *(u32x2*)(att + n * 256 + ((((m0 >> 3) ^ (n & 15)) << 4) | ((m0 & 7) << 1))) = mk2(pack2(o[0], o[1]), pack2(o[2], o[3]));
        }
      }
    }
    __syncthreads();
    if (outp) {
      const int n = w * 32 + r;
      f32x16 y[4];
#pragma unroll
      for (int et = 0; et < 4; ++et) {
        f32x16 a;
#pragma unroll
        for (int i = 0; i < 16; ++i) a[i] = 0.f;
        const int e = et * 32 + r;
#pragma unroll
        for (int s = 0; s < 4; ++s) {
          const bf16x8 bs = *(const bf16x8*)(stf + e * 128 + (((2 * s + h5) ^ ((e >> 1) & 7)) << 4));
          a = MFMA32(qf[s], bs, a);
        }
#pragma unroll
        for (int i = 0; i < 16; ++i) {
          const int nn = w * 32 + crow(i, h5);
          y[et][i] = a[i] * __builtin_amdgcn_exp2f(lgf2 * (float)(nn + 1));
        }
        __builtin_amdgcn_sched_barrier(0);
      }
      {
        const u16* img = RS + (size_t)((cidx < 16) ? (cidx & 3) : 4) * 8192;
#pragma unroll
        for (int et = 0; et < 4; ++et) {
          f32x16 a;
#pragma unroll
          for (int i = 0; i < 16; ++i) a[i] = 0.f;
          const int e = et * 32 + r;
#pragma unroll
          for (int s = 0; s < 4; ++s) {
            const bf16x8 bs = *(const bf16x8*)(img + e * 64 + s * 16 + h5 * 8);
            a = MFMA32(qf[s], bs, a);
          }
#pragma unroll
          for (int i = 0; i < 16; ++i) {
            const int nn = w * 32 + crow(i, h5);
            y[et][i] += a[i] * __builtin_amdgcn_exp2f(lgb2 * (float)(128 - nn));
          }
          __builtin_amdgcn_sched_barrier(0);
        }
      }
#pragma unroll 2
      for (int s = 0; s < 8; ++s) {
        const bf16x8 af = *(const bf16x8*)(att + n * 256 + (((2 * s + h5) ^ (n & 15)) << 4));
#pragma unroll
        for (int et = 0; et < 4; ++et) {
          const bf16x8 bv = *(const bf16x8*)(VT + (size_t)(et * 32 + r) * VT_LD + cidx * 128 + s * 16 + h5 * 8);
          y[et] = MFMA32(af, bv, y[et]);
        }
      }
      const float* gn = p.ret_norm_g + l * 1024 + h * 128;
      float gam[4];
#pragma unroll
      for (int et = 0; et < 4; ++et) gam[et] = gn[et * 32 + r];
#pragma unroll
      for (int i = 0; i < 16; ++i) {
        float s1 = y[0][i] + y[1][i] + y[2][i] + y[3][i];
        float s2 = y[0][i] * y[0][i] + y[1][i] * y[1][i] + y[2][i] * y[2][i] + y[3][i] * y[3][i];
#pragma unroll
        for (int m = 16; m >= 1; m >>= 1) { s1 += __shfl_xor(s1, m, 64); s2 += __shfl_xor(s2, m, 64); }
        const float mu = s1 * (1.f / 128.f);
        const float var = fmaxf(s2 * (1.f / 128.f) - mu * mu, 0.f);
        const float rs = rsqrtf(var + 1e-5f);
        const int row = row0 + w * 32 + crow(i, h5);
        u16* zp = ZGR + (size_t)row * 1024 + h * 128 + r;
#pragma unroll
        for (int et = 0; et < 4; ++et) y[et][i] = (y[et][i] - mu) * rs * gam[et];
        (void)zp;
      }
      {
        u16* zb = ZGR + (size_t)(row0 + w * 32 + 4 * h5) * 1024 + h * 128 + r;
#pragma unroll
        for (int half = 0; half < 2; ++half) {
          u16 zv[4][8];
#pragma unroll
          for (int et = 0; et < 4; ++et)
#pragma unroll
            for (int ii = 0; ii < 8; ++ii) {
              const int i = half * 8 + ii;
              zv[et][ii] = zb[(size_t)((i & 3) + 8 * (i >> 2)) * 1024 + et * 32];
            }
#pragma unroll
          for (int et = 0; et < 4; ++et)
#pragma unroll
            for (int ii = 0; ii < 8; ++ii) {
              const int i = half * 8 + ii;
              zb[(size_t)((i & 3) + 8 * (i >> 2)) * 1024 + et * 32] = f2bf(y[et][i] * siluf_(bf2f(zv[et][ii])));
            }
        }
      }
    }
    state_update(S, kt, VT + (size_t)(w * 32) * VT_LD + cidx * 128, cdf, lane);
  }
  __syncthreads();
}

DI int shift_nbr(int row, int col) {
  if (row < NL) {
    const int t = row & 2047, tc = t & 63, tr = t >> 6;
    switch (col & 3) {
      case 0: return tc > 0 ? row - 1 : -1;
      case 1: return tc < 63 ? row + 1 : -1;
      case 2: return tr > 0 ? row - 64 : -1;
      default: return tr < 31 ? row + 64 : -1;
    }
  } else {
    const int t = (row - NL) & 255;
    if ((col & 1) == 0) return t > 0 ? row - 1 : -1;
    return t < 255 ? row + 1 : -1;
  }
}
DI float zshift(const u16* __restrict__ Z, int row, int nrow, int col, float mu) {
  const float v = bf2f(Z[(size_t)row * RWB + col]);
  const float nv = nrow >= 0 ? bf2f(Z[(size_t)nrow * RWB + col]) : 0.f;
  return v + mu * (nv - v);
}

constexpr int TC = 16;
typedef __attribute__((ext_vector_type(4))) float f32x4_t;
#define MFMA16(a, b, c) __builtin_amdgcn_mfma_f32_16x16x32_bf16((a), (b), (c), 0, 0, 0)
DI void scan_item(const Params& p, int l, bool ctx_out, int item, char* smem) {
  const int dir = item & 1, h = (item >> 1) & 7, b = item >> 4;
  const int tid = ltid(), lane = tid & 63, w = tid >> 6;
  const int c = lane, tg = w;
  const int kg = lane & 15, rg = lane >> 4;
  const u16* __restrict__ Z = (const u16*)(p.ws + OFF_ZRW);
  u16* YD = (u16*)(p.ws + OFF_QK) + (size_t)dir * NT * 512;
  float* BON = (float*)(p.ws + OFF_BONUS) + (size_t)dir * NT * 8;
  float* zs = (float*)smem;
  float* ops = zs + TC * 3 * 64;
  u16* zwb = (u16*)(ops + TC * 4 * 64);
  u16* zab = zwb + 16 * 72;
  const int hc = h * 64 + c;
  const int cl = lane & 15, q4 = lane >> 4;
  bf16x8 bw[2], ba[2];
  {
    const float* w2 = p.rwkv_w2 + (size_t)(l * 2 + dir) * 64 * 512 + h * 64 + 16 * w + cl;
    const float* a2 = p.rwkv_a2 + (size_t)(l * 2 + dir) * 64 * 512 + h * 64 + 16 * w + cl;
#pragma unroll
    for (int s = 0; s < 2; ++s)
#pragma unroll
      for (int jj = 0; jj < 8; ++jj) {
        const int j = s * 32 + q4 * 8 + jj;
        bw[s][jj] = (short)f2bf(w2[j * 512]);
        ba[s][jj] = (short)f2bf(a2[j * 512]);
      }
  }
  const int hc2 = h * 64 + 16 * w + cl;
  const float w0c = p.rwkv_w0[(l * 2 + dir) * 512 + hc2], a0c = p.rwkv_a0[(l * 2 + dir) * 512 + hc2];
  const float kac = p.rwkv_k_a[l * 512 + hc2];
  const float kkc = p.rwkv_k_k[l * 512 + hc];
  f32x4 rk4;
#pragma unroll
  for (int j = 0; j < 4; ++j) rk4[j] = 0.5f * p.rwkv_r_k[l * 512 + h * 64 + 4 * kg + j];
  const int gcol[5] = {hc, 512 + hc, 1024 + hc, 1536 + 64 * dir + c, 1664 + 64 * dir + c};
  float muv[5];
#pragma unroll
  for (int g = 0; g < 5; ++g) muv[g] = p.rwkv_mu[l * RWB + gcol[g]];
  float S[4][4];
#pragma unroll
  for (int a = 0; a < 4; ++a)
#pragma unroll
    for (int j = 0; j < 4; ++j) S[a][j] = 0.f;
  __syncthreads();
  u16 raw[4][5][2];
  const int NCH = 256 / TC + 2048 / TC;
#define CHUNK_INFO(ci, n_, rbase_, c0_) \
  const int n_ = (ci) < 256 / TC ? 256 : 2048; \
  const int rbase_ = (ci) < 256 / TC ? NL + b * 256 : b * 2048; \
  const int c0_ = (ci) < 256 / TC ? (ci) * TC : ((ci) - 256 / TC) * TC;
#define ISSUE_LOADS(ci) { \
    CHUNK_INFO(ci, n__, rb__, c0__) \
    _Pragma("unroll") for (int q = 0; q < 4; ++q) { \
      const int sidx = c0__ + tg * 4 + q; \
      const int row = rb__ + (dir == 0 ? sidx : n__ - 1 - sidx); \
      const int nrow = shift_nbr(row, c); \
      _Pragma("unroll") for (int g = 0; g < 5; ++g) { \
        raw[q][g][0] = Z[(size_t)row * RWB + gcol[g]]; \
        raw[q][g][1] = nrow >= 0 ? Z[(size_t)nrow * RWB + gcol[g]] : (u16)0; \
      } \
    } }
  ISSUE_LOADS(0)
#pragma unroll 1
  for (int ci = 0; ci < NCH; ++ci) {
    CHUNK_INFO(ci, n, rbase, c0)
    const bool emit = (ci >= 256 / TC) || ctx_out;
#pragma unroll
    for (int q = 0; q < 4; ++q) {
      const int i = tg * 4 + q;
      float zv[5];
#pragma unroll
      for (int g = 0; g < 5; ++g) {
        const float v0 = bf2f(raw[q][g][0]), v1 = bf2f(raw[q][g][1]);
        zv[g] = v0 + muv[g] * (v1 - v0);
      }
      zs[(i * 3 + 0) * 64 + c] = zv[0];
      zs[(i * 3 + 1) * 64 + c] = zv[1];
      zs[(i * 3 + 2) * 64 + c] = zv[2];
      zwb[i * 72 + c] = f2bf(tanhf_(zv[3]));
      zab[i * 72 + c] = f2bf(zv[4]);
      const float kkr = zv[1] * kkc;
      const float ss = wave_sum_dpp(kkr * kkr);
      ops[(i * 4 + 1) * 64 + c] = kkr * rsqrtf(ss + 1e-12f);
    }
    __syncthreads();
    {
      f32x4_t accw = {0.f, 0.f, 0.f, 0.f}, acca = {0.f, 0.f, 0.f, 0.f};
#pragma unroll
      for (int s = 0; s < 2; ++s) {
        const bf16x8 aw = *(const bf16x8*)(zwb + cl * 72 + s * 32 + q4 * 8);
        const bf16x8 aa = *(const bf16x8*)(zab + cl * 72 + s * 32 + q4 * 8);
        accw = MFMA16(aw, bw[s], accw);
        acca = MFMA16(aa, ba[s], acca);
      }
      const int ch = 16 * w + cl;
#pragma unroll
      for (int rr = 0; rr < 4; ++rr) {
        const int i = 4 * q4 + rr;
        const float wl = accw[rr] + w0c, al = acca[rr] + a0c;
        const float sp = __logf(1.f + __expf(-wl));
        const float dec = __expf(-__expf(-sp - 0.5f));
        const float av = sigmoidf_(al);
        const float zk = zs[(i * 3 + 1) * 64 + ch];
        const float kkn = ops[(i * 4 + 1) * 64 + ch];
        ops[(i * 4 + 0) * 64 + ch] = dec;
        ops[(i * 4 + 2) * 64 + ch] = kkn * av;
        ops[(i * 4 + 3) * 64 + ch] = zk * (1.f + (av - 1.f) * kac);
      }
    }
    if (ci + 1 < NCH) ISSUE_LOADS(ci + 1)
    __syncthreads();
    f32x4 nw4 = *(const f32x4*)(ops + 0 * 64 + 4 * kg);
    f32x4 nkk4 = *(const f32x4*)(ops + 1 * 64 + 4 * kg);
    f32x4 nb4 = *(const f32x4*)(ops + 2 * 64 + 4 * kg);
    f32x4 nk4 = *(const f32x4*)(ops + 3 * 64 + 4 * kg);
    f32x4 nr4 = *(const f32x4*)(zs + 0 * 64 + 4 * kg);
    f32x4 nv4 = *(const f32x4*)(zs + 2 * 64 + 16 * w + 4 * rg);
#pragma unroll 2
    for (int i = 0; i < TC; ++i) {
      const f32x4 w4 = nw4, kk4 = nkk4, b4 = nb4, k4 = nk4, r4 = nr4, v4 = nv4;
      if (i + 1 < TC) {
        const int i1 = i + 1;
        nw4 = *(const f32x4*)(ops + (i1 * 4 + 0) * 64 + 4 * kg);
        nkk4 = *(const f32x4*)(ops + (i1 * 4 + 1) * 64 + 4 * kg);
        nb4 = *(const f32x4*)(ops + (i1 * 4 + 2) * 64 + 4 * kg);
        nk4 = *(const f32x4*)(ops + (i1 * 4 + 3) * 64 + 4 * kg);
        nr4 = *(const f32x4*)(zs + (i1 * 3 + 0) * 64 + 4 * kg);
        nv4 = *(const f32x4*)(zs + (i1 * 3 + 2) * 64 + 16 * w + 4 * rg);
      }
      float sk[4], y[4];
#pragma unroll
      for (int a = 0; a < 4; ++a) {
        sk[a] = S[a][0] * kk4[0] + S[a][1] * kk4[1] + S[a][2] * kk4[2] + S[a][3] * kk4[3];
        if (dir == 1) y[a] = S[a][0] * r4[0] + S[a][1] * r4[1] + S[a][2] * r4[2] + S[a][3] * r4[3];
      }
#pragma unroll
      for (int a = 0; a < 4; ++a) sk[a] = allred16(sk[a]);
#pragma unroll
      for (int a = 0; a < 4; ++a)
#pragma unroll
        for (int j = 0; j < 4; ++j) S[a][j] = S[a][j] * w4[j] + (v4[a] * k4[j] - sk[a] * b4[j]);
      if (dir == 0) {
#pragma unroll
        for (int a = 0; a < 4; ++a) y[a] = S[a][0] * r4[0] + S[a][1] * r4[1] + S[a][2] * r4[2] + S[a][3] * r4[3];
      }
      if (emit) {
        float bo = r4[0] * k4[0] * rk4[0] + r4[1] * k4[1] * rk4[1] + r4[2] * k4[2] * rk4[2] + r4[3] * k4[3] * rk4[3];
        bo = allred16(bo);
#pragma unroll
        for (int a = 0; a < 4; ++a) y[a] = allred16(y[a]);
        if (kg == 0) {
          const int sidx = c0 + i;
          const int row = rbase + (dir == 0 ? sidx : n - 1 - sidx);
          *(u32x2*)(YD + (size_t)row * 512 + h * 64 + 16 * w + 4 * rg) = mk2(pack2(y[0], y[1]), pack2(y[2], y[3]));
          if (tid == 0) BON[(size_t)row * 8 + h] = bo;
        }
      }
    }
    __syncthreads();
  }
#undef ISSUE_LOADS
#undef CHUNK_INFO
}

DI void post1_rows(const Params& p, int l, int nrows, int bid, int nb) {
  const int lane = ltid() & 63, wid = ltid() >> 6;
  const int nw = nb * 4;
  const u16* __restrict__ Z = (const u16*)(p.ws + OFF_ZRW);
  const u16* __restrict__ YF = (const u16*)(p.ws + OFF_QK);
  const u16* __restrict__ YB = YF + (size_t)NT * 512;
  const float* __restrict__ BF = (const float*)(p.ws + OFF_BONUS);
  const float* __restrict__ BB = BF + (size_t)NT * 8;
  u16* __restrict__ U = (u16*)(p.ws + OFF_V);
  u16* __restrict__ SG = U + (size_t)NT * 512;
  const float* __restrict__ mu = p.rwkv_mu + l * RWB;
  const float* __restrict__ ng = p.rwkv_norm_g + l * 512;
  for (int row = bid * 4 + wid; row < nrows; row += nw) {
    const int nrow = shift_nbr(row, lane);
    float yv[8], vsv[8], bonv[8];
#pragma unroll
    for (int hh = 0; hh < 8; ++hh) {
      const int col = hh * 64 + lane;
      yv[hh] = bf2f(YF[(size_t)row * 512 + col]) + bf2f(YB[(size_t)row * 512 + col]);
      bonv[hh] = BF[(size_t)row * 8 + hh] + BB[(size_t)row * 8 + hh];
      vsv[hh] = zshift(Z, row, nrow, 1024 + col, mu[1024 + col]);
    }
#pragma unroll
    for (int hh = 0; hh < 8; ++hh) {
      const int col = hh * 64 + lane;
      const float y = yv[hh];
      const float mean = wave_sum_dpp(y) * (1.f / 64.f);
      const float d = y - mean;
      const float var = wave_sum_dpp(d * d) * (1.f / 64.f);
      float o = d * rsqrtf(var + 64e-5f) * ng[col];
      o += bonv[hh] * vsv[hh];
      U[(size_t)row * 512 + col] = f2bf(o);
    }
#pragma unroll
    for (int jj = 0; jj < 2; ++jj) {
      const int col = 1792 + jj * 64 + lane;
      const float zg = zshift(Z, row, nrow, col, mu[col]);
      SG[(size_t)row * 128 + jj * 64 + lane] = f2bf(sigmoidf_(zg));
    }
  }
}

constexpr int NPHASE = 1 + 11 * 2 + 1;

DI void run_phase(const Params& p, int ph, int bid, int nb, char* smem) {
  if (ph == 0) {
    for (int it = bid; it < 192 + WC_TOTAL; it += nb) {
      if (it < 192) mods_item(p, it, smem); else wconv_item(p, 0, it - 192, smem);
    }
    return;
  }
  if (ph == NPHASE - 1) { final_norm(p, bid, nb); return; }
  const int l = (ph - 1) / 11, s = (ph - 1) % 11;
  const bool ctx_out = (l == 0);
  const int mrows = ctx_out ? NT : NL;
  switch (s) {
    case 0:
      norm_rows(p, l, 0, NT, bid, nb);
      if (l > 0) for (int it = bid; it < WC_TOTAL; it += nb) wconv_item(p, l, it, smem);
      break;
    case 1: gemm_in_phase<4>(p, l, bid, nb, smem); break;
    case 2: for (int it = bid; it < 512; it += nb) retention_item(p, l, ctx_out, it, smem); break;
    case 3: for (int it = bid; it < 256; it += nb) scan_item(p, l, ctx_out, it, smem); break;
    case 4: post1_rows(p, l, mrows, bid, nb); break;
    case 5: gemm_post2_phase(p, mrows, bid, nb, smem); break;
    case 6: gemm_merge_phase(p, mrows, bid, nb, smem); break;
    case 7: if (l == 0) gemm_out_phase<2>(p, l, mrows, bid, nb, smem); else gemm_out_phase<4>(p, l, mrows, bid, nb, smem); break;
    case 8: norm_rows(p, l, 1, mrows, bid, nb); break;
    case 9: gemm_ffn1_phase<4>(p, mrows, bid, nb, smem); break;
    case 10: if (l == 0) gemm_ffn2_phase<2>(p, l, mrows, bid, nb, smem); else gemm_ffn2_phase<4>(p, l, mrows, bid, nb, smem); break;
  }
}


#define XB_TMO      128
#define XB_XCNT(j)  (256  + 64 * (j))
#define XB_XSUB(j)  (1280 + 64 * (j))
#define XB_XGEN(j)  (2304 + 64 * (j))
#define XB_TOP      3328
#define XB_TOPGEN   3392
#define XCD_BAR_WORDS 3456
#define XB_SPIN_CAP (1u << 22)
#define LAS __attribute__((address_space(3)))
DI unsigned xb_ld(unsigned* p) { return __hip_atomic_load(p, __ATOMIC_RELAXED, __HIP_MEMORY_SCOPE_AGENT); }
DI unsigned xb_add(unsigned* p, unsigned v) { return __hip_atomic_fetch_add(p, v, __ATOMIC_RELAXED, __HIP_MEMORY_SCOPE_AGENT); }
DI unsigned xb_xcc_id() { return (unsigned)__builtin_amdgcn_s_getreg((3 << 11) | 20) & 0xFu; }
#define XB_SPIN(cond, bar) do { unsigned _sp = 0; while (cond) { __builtin_amdgcn_s_sleep(1); \
    if ((++_sp & 255u) == 0u) { if (xb_ld(&(bar)[XB_TMO])) break; if (_sp > XB_SPIN_CAP) { atomicAdd(&(bar)[XB_TMO], 1u); break; } } } } while (0)
struct XcdBarrier { unsigned* bar; unsigned x; volatile LAS unsigned* st; };
DI XcdBarrier xcd_barrier_post(unsigned* bar, volatile LAS unsigned* st) {
  XcdBarrier b; b.bar = bar; b.x = xb_xcc_id(); b.st = st;
  if (threadIdx_raw() == 0) (void)xb_add(&bar[XB_XCNT(b.x)], 1u);
  return b;
}
DI void xcd_barrier_complete(unsigned* bar, unsigned x, unsigned& nloc, unsigned& nx) {
  const unsigned G = gridDim.x * gridDim.y * gridDim.z;
  unsigned sum, cnt, mine, sp = 0u;
  for (;;) {
    sum = 0u; cnt = 0u; mine = 0u;
#pragma unroll
    for (unsigned j = 0; j < 16; ++j) { const unsigned c = xb_ld(&bar[XB_XCNT(j)]); sum += c; cnt += (c > 0u) ? 1u : 0u; mine = (j == x) ? c : mine; }
    if (sum == G) break;
    __builtin_amdgcn_s_sleep(1);
    if ((++sp & 255u) == 0u) { if (xb_ld(&bar[XB_TMO])) break; if (sp > XB_SPIN_CAP) { atomicAdd(&bar[XB_TMO], 1u); break; } }
  }
  nloc = mine > 0u ? mine : 1u; nx = cnt > 0u ? cnt : 1u;
}
DI void xcd_barrier(const XcdBarrier& b) {
  asm volatile("s_waitcnt vmcnt(0)" ::: "memory");
  __syncthreads();
  if (threadIdx_raw() == 0) {
    unsigned* bar = b.bar;
    __builtin_amdgcn_s_waitcnt(0);
    unsigned nloc = b.st[0], nx = b.st[1];
    if (nloc == 0u) { xcd_barrier_complete(bar, b.x, nloc, nx); b.st[0] = nloc; b.st[1] = nx; }
    const unsigned old = xb_add(&bar[XB_XSUB(b.x)], 1u);
    const unsigned gen = old / nloc;
    if (old + 1u == (gen + 1u) * nloc) {
      __builtin_amdgcn_fence(__ATOMIC_RELEASE, "agent");
      asm volatile("s_waitcnt vmcnt(0)" ::: "memory");
      const unsigned og = xb_add(&bar[XB_TOP], 1u);
      const unsigned tg = og / nx;
      if (og + 1u == (tg + 1u) * nx) xb_add(&bar[XB_TOPGEN], 1u);
      else XB_SPIN(xb_ld(&bar[XB_TOPGEN]) == tg, bar);
      __builtin_amdgcn_fence(__ATOMIC_ACQUIRE, "agent");
      xb_add(&bar[XB_XGEN(b.x)], 1u);
      asm volatile("s_waitcnt vmcnt(0)" ::: "memory");
    } else {
      XB_SPIN(xb_ld(&bar[XB_XGEN(b.x)]) == gen, bar);
      __builtin_amdgcn_fence(__ATOMIC_ACQUIRE, "agent");
      asm volatile("s_waitcnt vmcnt(0)" ::: "memory");
    }
  }
  __syncthreads();
}

#if MEGA
__global__ void __launch_bounds__(256, 2) mega_kernel(Params p) {
  __shared__ __attribute__((aligned(16))) char smem[SMEM_BYTES];
  cg::grid_group grid = cg::this_grid();
  __shared__ int s_vbid;
  __shared__ u32x4 xb_words;
  if (threadIdx_raw() == 0) { u32x4 z = {0u, 0u, 0u, 0u}; xb_words = z; }
  __syncthreads();
  XcdBarrier xb = xcd_barrier_post((unsigned*)(p.ws + OFF_BAR), (volatile LAS unsigned*)&xb_words);
  if (threadIdx.x == 0) {
    int* tab = (int*)(p.ws + OFF_TAB);
    const unsigned xcc = (unsigned)__builtin_amdgcn_s_getreg(20 | (3 << 11)) & 0xfu;
    const unsigned cuk = ((unsigned)__builtin_amdgcn_s_getreg(63492) >> 8) & 0xffu;
    const int rank = atomicAdd(&tab[(xcc & 7) * 256 + cuk], 1);
    int v;
    if (rank == 0) v = atomicAdd(&tab[2048], 1);
    else v = (int)gridDim.x - 1 - atomicAdd(&tab[2049], 1);
    s_vbid = v;
  }
  __syncthreads();
  const int vbid = s_vbid;
#pragma unroll 1
  for (int ph = 0; ph < NPHASE; ++ph) {
    Params q = p;
    {
      size_t zoff = 0;
      asm volatile("" : "+s"(zoff));
      q.ws = p.ws + zoff;
      q.out = p.out + zoff;
    }
    run_phase(q, ph, vbid, gridDim.x, smem);
    if (ph + 1 < NPHASE) {
      if (ph == 0) grid.sync();
      else xcd_barrier(xb);
    }
  }
}
#else
__global__ void __launch_bounds__(256, 2) phase_kernel(Params p, int ph) {
  __shared__ __attribute__((aligned(16))) char smem[SMEM_BYTES];
  run_phase(p, ph, blockIdx.x, gridDim.x, smem);
}
#endif

extern "C" void kernel_launch(void* const* d_in, const int* in_sizes, int n_in, void* d_out, int out_size, void* d_ws,
                              size_t ws_size, hipStream_t stream) {
  if (ws_size < WS_NEED) { fprintf(stderr, "workspace too small: %zu < %zu\n", ws_size, (size_t)WS_NEED); return; }
  Params p{};
  const float** fp = (const float**)&p;
  for (int i = 0; i < 27; ++i) fp[i] = (const float*)d_in[i];
  p.out = (float*)d_out;
  p.ws = (char*)d_ws;
#if MEGA
  static int grid_blocks = 0;
  if (!grid_blocks) {
    int dev = 0, cus = 0, per_cu = 0;
    hipGetDevice(&dev);
    hipDeviceGetAttribute(&cus, hipDeviceAttributeMultiprocessorCount, dev);
    hipOccupancyMaxActiveBlocksPerMultiprocessor(&per_cu, mega_kernel, 256, 0);
    if (per_cu > 2) per_cu = 2;
    if (per_cu < 2) { fprintf(stderr, "occupancy query says %d per CU; forcing 2\n", per_cu); per_cu = 2; }
    grid_blocks = cus * per_cu;
  }
  hipMemsetAsync((char*)d_ws + OFF_TAB, 0, TAB_BYTES, stream);
  void* args[] = {&p};
  hipError_t e = hipLaunchCooperativeKernel((void*)mega_kernel, dim3(grid_blocks), dim3(256), args, 0, stream);
  if (e != hipSuccess) fprintf(stderr, "cooperative launch failed: %s (grid %d)\n", hipGetErrorString(e), grid_blocks);
#else
  for (int ph = 0; ph < NPHASE; ++ph) phase_kernel<<<512, 256, 0, stream>>>(p, ph);
#endif
}
```

```cpp
#include <hip/hip_runtime.h>
#include <hip/hip_cooperative_groups.h>
#include <cstdio>
namespace cg = cooperative_groups;

#ifndef MEGA
#define MEGA 1
#endif

#define DI __device__ __forceinline__
typedef unsigned short u16;
typedef __attribute__((ext_vector_type(8))) short bf16x8;
typedef __attribute__((ext_vector_type(4))) short s16x4;
typedef __attribute__((ext_vector_type(16))) float f32x16;
typedef __attribute__((ext_vector_type(4))) float f32x4;
typedef __attribute__((ext_vector_type(4))) unsigned u32x4;
typedef __attribute__((ext_vector_type(2))) unsigned u32x2;

constexpr int D = 1024, NB = 16, SEQ = 2048, CTX = 256;
constexpr int NL = NB * SEQ, NC = NB * CTX, NT = NL + NC;
constexpr int WIN = 7040, RWB = 1920, FFN = 2816;
constexpr int NIN = 4992;
constexpr int VT_LD = 2304;
constexpr int SMEM_BYTES = 71680;

constexpr size_t WT_IN = 0, WT_A = 7208960, WT_B = 8257536, WT_OUT = 8781824, WT_13 = 9830400, WT_2 = 15597568,
                 WT_G2 = 18481152, WT_TOTAL = 18546688;
constexpr size_t ACTB = (size_t)NT * 1024 * 2;
constexpr size_t OFF_WT = 0;
constexpr size_t OFF_H = WT_TOTAL * 2;
constexpr size_t OFF_QK = OFF_H + ACTB;
constexpr size_t OFF_V = OFF_QK + ACTB;
constexpr size_t OFF_ZGR = OFF_V + ACTB;
constexpr size_t OFF_ZRW = OFF_ZGR + ACTB;
constexpr size_t OFF_CTXRES = OFF_ZRW + (size_t)NT * RWB * 2;
constexpr size_t OFF_MODS = OFF_CTXRES + (size_t)NC * 1024 * 4;
constexpr size_t OFF_BONUS = OFF_MODS + (size_t)2 * 17 * 6144 * 4;
constexpr size_t OFF_TAB = OFF_BONUS + (size_t)NT * 8 * 2 * 4;
constexpr size_t OFF_BAR = OFF_TAB + 8448;
constexpr size_t TAB_BYTES = 8448 + 3456 * 4;
constexpr size_t OFF_RS1 = ((OFF_TAB + TAB_BYTES + 255) / 256) * 256;
constexpr size_t WS_NEED = OFF_RS1 + (size_t)512 * 4 * 16384;

struct Params {
  const float *x, *c, *ctx, *c_ctx, *mod_w, *mod_b, *norm1_g, *norm2_g, *w_in, *ret_decay, *ret_norm_g, *rwkv_mu,
      *rwkv_w0, *rwkv_w2, *rwkv_a0, *rwkv_a2, *rwkv_g2, *rwkv_k_k, *rwkv_k_a, *rwkv_r_k, *rwkv_norm_g, *w_branch_a,
      *w_branch_b, *w_out, *ffn_w13, *ffn_w2, *final_norm_g;
  float* out;
  char* ws;
};

typedef float f32x2_t __attribute__((ext_vector_type(2)));
typedef __bf16 bf16x2_t __attribute__((ext_vector_type(2)));
DI u16 f2bf(float x) { __bf16 r = (__bf16)x; return __builtin_bit_cast(u16, r); }
DI float bf2f(u16 v) { return __uint_as_float(((unsigned)v) << 16); }
DI u32x4 mk4(unsigned a, unsigned b, unsigned c, unsigned d) { u32x4 v; v[0] = a; v[1] = b; v[2] = c; v[3] = d; return v; }
DI u32x2 mk2(unsigned a, unsigned b) { u32x2 v; v[0] = a; v[1] = b; return v; }
DI unsigned pack2(float a, float b) { f32x2_t v = {a, b}; bf16x2_t r = __builtin_convertvector(v, bf16x2_t); return __builtin_bit_cast(unsigned, r); }
DI float frcp(float x) { return __builtin_amdgcn_rcpf(x); }
DI float sigmoidf_(float x) { return frcp(1.f + __expf(-x)); }
DI float siluf_(float x) { return x * frcp(1.f + __expf(-x)); }
DI float tanhf_(float x) { return 1.f - 2.f * frcp(__expf(2.f * x) + 1.f); }
DI float wave_sum(float v) {
#pragma unroll
  for (int m = 32; m >= 1; m >>= 1) v += __shfl_xor(v, m, 64);
  return v;
}
DI float allred16(float x) {
  x += __int_as_float(__builtin_amdgcn_update_dpp(0, __float_as_int(x), 0xB1, 0xF, 0xF, true));
  x += __int_as_float(__builtin_amdgcn_update_dpp(0, __float_as_int(x), 0x4E, 0xF, 0xF, true));
  x += __int_as_float(__builtin_amdgcn_update_dpp(0, __float_as_int(x), 0x141, 0xF, 0xF, true));
  x += __int_as_float(__builtin_amdgcn_update_dpp(0, __float_as_int(x), 0x140, 0xF, 0xF, true));
  return x;
}
DI int ltid() { int t = __builtin_amdgcn_workitem_id_x(); asm volatile("" : "+v"(t)); return t; }
DI int threadIdx_raw() { return __builtin_amdgcn_workitem_id_x(); }
DI int launder(int x) { asm volatile("" : "+v"(x)); return x; }
DI float wave_sum_dpp(float x) {
  x = allred16(x);
  const int xi = __float_as_int(x);
  const float s0 = __int_as_float(__builtin_amdgcn_readlane(xi, 0)), s1 = __int_as_float(__builtin_amdgcn_readlane(xi, 16));
  const float s2 = __int_as_float(__builtin_amdgcn_readlane(xi, 32)), s3 = __int_as_float(__builtin_amdgcn_readlane(xi, 48));
  return (s0 + s1) + (s2 + s3);
}
#define MFMA32(a, b, c) __builtin_amdgcn_mfma_f32_32x32x16_bf16((a), (b), (c), 0, 0, 0)
DI int crow(int reg, int h5) { return (reg & 3) + 8 * (reg >> 2) + 4 * h5; }

DI const float* mods_ptr(const Params& p, int l, int mrow, int chunk) {
  return (const float*)(p.ws + OFF_MODS) + ((size_t)(l * 17 + mrow) * 6144 + chunk * 1024);
}
DI int row_modrow(int row) { return row < NL ? (row >> 11) : 16; }

DI void mods_item(const Params& p, int item, char* smem) {
  const int l = item / 96, cg0 = (item % 96) * 64;
  const int tid = ltid(), lane = tid & 63, wid = tid >> 6;
  float acc[17];
#pragma unroll
  for (int b = 0; b < 17; ++b) acc[b] = 0.f;
  const float* W = p.mod_w + (size_t)l * 1024 * 6144 + cg0 + lane;
  for (int kb = 0; kb < 4; ++kb) {
    const int k0 = wid * 256 + kb * 64;
    float s[17];
#pragma unroll
    for (int b = 0; b < 17; ++b) {
      float cv = (b < 16) ? p.c[b * 1024 + k0 + lane] : p.c_ctx[k0 + lane];
      s[b] = siluf_(cv);
    }
#pragma unroll 8
    for (int kk = 0; kk < 64; ++kk) {
      float wv = W[(size_t)(k0 + kk) * 6144];
#pragma unroll
      for (int b = 0; b < 17; ++b) acc[b] += __shfl(s[b], kk, 64) * wv;
    }
  }
  float* red = (float*)smem;
  __syncthreads();
#pragma unroll
  for (int b = 0; b < 17; ++b) red[(wid * 17 + b) * 64 + lane] = acc[b];
  __syncthreads();
  float* mo = (float*)(p.ws + OFF_MODS);
  for (int e = tid; e < 17 * 64; e += 256) {
    int b = e >> 6, cc = e & 63;
    float v = red[(0 * 17 + b) * 64 + cc] + red[(1 * 17 + b) * 64 + cc] + red[(2 * 17 + b) * 64 + cc] +
              red[(3 * 17 + b) * 64 + cc] + p.mod_b[l * 6144 + cg0 + cc];
    mo[(size_t)(l * 17 + b) * 6144 + cg0 + cc] = v;
  }
  __syncthreads();
}

DI int map_in(int n) {
  if (n < 1024) {
    int p = n & 63, base = n & ~63;
    int d;
    if (p < 32) d = (p < 16) ? p : 32 + (p - 16);
    else { int pp = p - 32; d = (pp < 16) ? 16 + pp : 48 + (pp - 16); }
    return base + d;
  }
  return n;
}
DI int map_13(int n) {
  int q = n >> 6, r = n & 63;
  return (r < 32) ? (q * 32 + r) : (FFN + q * 32 + (r - 32));
}
template <int MAPK>
DI void wconv_tile(const float* __restrict__ W, int K, int Nsrc, u16* __restrict__ Wt, int kt, int nt,
                           char* smem) {
  float* tile = (float*)smem;
  const int tid = ltid();
  const int n = tid & 63;
  const int nd = nt * 64 + n;
  const int src = (MAPK == 1) ? map_in(nd) : (MAPK == 2 ? map_13(nd) : nd);
  __syncthreads();
#pragma unroll
  for (int i = 0; i < 16; ++i) {
    int k = i * 4 + (tid >> 6);
    tile[k * 65 + n] = W[(size_t)(kt * 64 + k) * Nsrc + src];
  }
  __syncthreads();
#pragma unroll
  for (int j = 0; j < 2; ++j) {
    int nn = (tid >> 3) + 32 * j, cch = tid & 7;
    unsigned pk[4];
#pragma unroll
    for (int i = 0; i < 4; ++i) pk[i] = pack2(tile[(cch * 8 + 2 * i) * 65 + nn], tile[(cch * 8 + 2 * i + 1) * 65 + nn]);
    *(u32x4*)(Wt + (size_t)(nt * 64 + nn) * K + kt * 64 + cch * 8) = mk4(pk[0], pk[1], pk[2], pk[3]);
  }
}

constexpr int WC_T_IN = 16 * 110, WC_T_A = 16 * 16, WC_T_B = 8 * 16, WC_T_OUT = 16 * 16, WC_T_13 = 16 * 88,
              WC_T_2 = 44 * 16, WC_T_G2 = 2 * 8;
constexpr int WC_TOTAL = WC_T_IN + WC_T_A + WC_T_B + WC_T_OUT + WC_T_13 + WC_T_2 + WC_T_G2;

DI void wconv_item(const Params& p, int l, int t, char* smem) {
  u16* wt = (u16*)(p.ws + OFF_WT);
  if (t < WC_T_IN) { wconv_tile<1>(p.w_in + (size_t)l * 1024 * WIN, 1024, WIN, wt + WT_IN, t % 16, t / 16, smem); return; }
  t -= WC_T_IN;
  if (t < WC_T_A) { wconv_tile<0>(p.w_branch_a + (size_t)l * 1024 * 1024, 1024, 1024, wt + WT_A, t % 16, t / 16, smem); return; }
  t -= WC_T_A;
  if (t < WC_T_B) { wconv_tile<0>(p.w_branch_b + (size_t)l * 512 * 1024, 512, 1024, wt + WT_B, t % 8, t / 8, smem); return; }
  t -= WC_T_B;
  if (t < WC_T_OUT) { wconv_tile<0>(p.w_out + (size_t)l * 1024 * 1024, 1024, 1024, wt + WT_OUT, t % 16, t / 16, smem); return; }
  t -= WC_T_OUT;
  if (t < WC_T_13) { wconv_tile<2>(p.ffn_w13 + (size_t)l * 1024 * 5632, 1024, 5632, wt + WT_13, t % 16, t / 16, smem); return; }
  t -= WC_T_13;
  if (t < WC_T_2) { wconv_tile<0>(p.ffn_w2 + (size_t)l * FFN * 1024, FFN, 1024, wt + WT_2, t % 44, t / 44, smem); return; }
  t -= WC_T_2;
  wconv_tile<0>(p.rwkv_g2 + (size_t)l * 128 * 512, 128, 512, wt + WT_G2, t % 2, t / 2, smem);
}

DI const float* resid_row(const Params& p, int l, int row) {
  if (row < NL) return (l == 0 ? p.x : p.out) + (size_t)row * 1024;
  return (l == 0 ? p.ctx : (const float*)(p.ws + OFF_CTXRES)) + (size_t)(row - NL) * 1024;
}
DI const float* resid_cur_row(const Params& p, int row) {
  if (row < NL) return p.out + (size_t)row * 1024;
  return (const float*)(p.ws + OFF_CTXRES) + (size_t)(row - NL) * 1024;
}
DI void norm_rows(const Params& p, int l, int which, int nrows, int bid, int nb) {
  const int lane = ltid() & 63, wid = ltid() >> 6;
  const int nw = nb * 4;
  u16* __restrict__ H = (u16*)(p.ws + OFF_H);
  const float* __restrict__ g = (which == 0 ? p.norm1_g : p.norm2_g) + l * 1024;
  const int per = (nrows + nw - 1) / nw;
  const int r0 = (bid * 4 + wid) * per;
  const int r1 = (r0 + per < nrows) ? r0 + per : nrows;
  int cur_mr = -1;
  f32x4 gs[4], shv[4];
#pragma unroll
  for (int i = 0; i < 4; ++i) { gs[i] = 0.f; shv[i] = 0.f; }
  for (int row = r0; row < r1; ++row) {
    const float* __restrict__ src = which == 0 ? resid_row(p, l, row) : resid_cur_row(p, row);
    const int mr = row_modrow(row);
    if (mr != cur_mr) {
      cur_mr = mr;
      const float* __restrict__ sh = mods_ptr(p, l, mr, which == 0 ? 0 : 3);
      const float* __restrict__ sc = mods_ptr(p, l, mr, which == 0 ? 1 : 4);
#pragma unroll
      for (int i = 0; i < 4; ++i) {
        const int k = i * 256 + lane * 4;
        const f32x4 gg = *(const f32x4*)(g + k), s2 = *(const f32x4*)(sc + k);
        shv[i] = *(const f32x4*)(sh + k);
        gs[i][0] = gg[0] * (1.f + s2[0]); gs[i][1] = gg[1] * (1.f + s2[1]);
        gs[i][2] = gg[2] * (1.f + s2[2]); gs[i][3] = gg[3] * (1.f + s2[3]);
      }
    }
    f32x4 v[4];
    float ss = 0.f;
#pragma unroll
    for (int i = 0; i < 4; ++i) {
      v[i] = *(const f32x4*)(src + i * 256 + lane * 4);
      ss += v[i][0] * v[i][0] + v[i][1] * v[i][1] + v[i][2] * v[i][2] + v[i][3] * v[i][3];
    }
    ss = wave_sum_dpp(ss);
    const float rstd = rsqrtf(ss * (1.f / 1024.f) + 1e-6f);
#pragma unroll
    for (int i = 0; i < 4; ++i) {
      const int k = i * 256 + lane * 4;
      const float o0 = v[i][0] * rstd * gs[i][0] + shv[i][0];
      const float o1 = v[i][1] * rstd * gs[i][1] + shv[i][1];
      const float o2 = v[i][2] * rstd * gs[i][2] + shv[i][2];
      const float o3 = v[i][3] * rstd * gs[i][3] + shv[i][3];
      *(u32x2*)(H + (size_t)row * 1024 + k) = mk2(pack2(o0, o1), pack2(o2, o3));
    }
  }
}
DI void final_norm(const Params& p, int bid, int nb) {
  const int lane = ltid() & 63, wid = ltid() >> 6;
  const int nw = nb * 4;
  for (int row = bid * 4 + wid; row < NL; row += nw) {
    float* src = p.out + (size_t)row * 1024;
    f32x4 v[4];
    float ss = 0.f;
#pragma unroll
    for (int i = 0; i < 4; ++i) {
      v[i] = *(const f32x4*)(src + i * 256 + lane * 4);
      ss += v[i][0] * v[i][0] + v[i][1] * v[i][1] + v[i][2] * v[i][2] + v[i][3] * v[i][3];
    }
    ss = wave_sum_dpp(ss);
    const float rstd = rsqrtf(ss * (1.f / 1024.f) + 1e-6f);
#pragma unroll
    for (int i = 0; i < 4; ++i) {
      const int k = i * 256 + lane * 4;
      f32x4 gg = *(const f32x4*)(p.final_norm_g + k);
      f32x4 o;
      o[0] = v[i][0] * rstd * gg[0]; o[1] = v[i][1] * rstd * gg[1]; o[2] = v[i][2] * rstd * gg[2]; o[3] = v[i][3] * rstd * gg[3];
      *(f32x4*)(src + k) = o;
    }
  }
}

DI void gemm_kloop(f32x16 (&acc)[2][2], const u16* __restrict__ A, int lda, const u16* __restrict__ B, int ldb, int K,
                   char* smem) {
  const int tid = ltid(), lane = tid & 63, wid = tid >> 6, wr = wid >> 1, wc = wid & 1;
  const int lr = tid >> 3, lc = tid & 7;
  const int r = lane & 31, h5 = lane >> 5;
  u32x4 ra0[4], rb0[4], ra1[4], rb1[4];
  const int nk = K >> 6;
  const u16* Ap = A + (size_t)lr * lda + lc * 8;
  const u16* Bp = B + (size_t)lr * ldb + lc * 8;
#define GLOAD(RA, RB, kt_) _Pragma("unroll") for (int i = 0; i < 4; ++i) { \
    RA[i] = *(const u32x4*)(Ap + (size_t)(32 * i) * lda + (kt_) * 64); \
    RB[i] = *(const u32x4*)(Bp + (size_t)(32 * i) * ldb + (kt_) * 64); }
#define LSTORE(RA, RB, buf_) _Pragma("unroll") for (int i = 0; i < 4; ++i) { \
    *(u32x4*)(smem + (buf_) * 16384 + woff + i * 4096) = RA[i]; \
    *(u32x4*)(smem + 32768 + (buf_) * 16384 + woff + i * 4096) = RB[i]; }
#define COMPUTE(buf_) __builtin_amdgcn_s_setprio(1); _Pragma("unroll") for (int s = 0; s < 4; ++s) { \
    const int ch = ((2 * s + h5) ^ sw) << 4; \
    bf16x8 a0 = *(const bf16x8*)(smem + (buf_) * 16384 + aoff + ch); \
    bf16x8 a1 = *(const bf16x8*)(smem + (buf_) * 16384 + aoff + 4096 + ch); \
    bf16x8 b0 = *(const bf16x8*)(smem + (buf_) * 16384 + boff + ch); \
    bf16x8 b1 = *(const bf16x8*)(smem + (buf_) * 16384 + boff + 4096 + ch); \
    acc[0][0] = MFMA32(a0, b0, acc[0][0]); \
    acc[0][1] = MFMA32(a0, b1, acc[0][1]); \
    acc[1][0] = MFMA32(a1, b0, acc[1][0]); \
    acc[1][1] = MFMA32(a1, b1, acc[1][1]); } __builtin_amdgcn_s_setprio(0);
  const int woff = lr * 128 + ((lc ^ ((lr >> 1) & 7)) << 4);
  const int sw = (r >> 1) & 7;
  const int aoff = (wr * 64 + r) * 128, boff = 32768 + (wc * 64 + r) * 128;
  GLOAD(ra0, rb0, 0)
  GLOAD(ra1, rb1, 1)
  __syncthreads();
  LSTORE(ra0, rb0, 0)
  __syncthreads();
#pragma unroll 1
  for (int kt = 0; kt < nk; kt += 2) {
    if (kt + 2 < nk) GLOAD(ra0, rb0, kt + 2)
    COMPUTE(0)
    LSTORE(ra1, rb1, 1)
    __syncthreads();
    if (kt + 3 < nk) GLOAD(ra1, rb1, kt + 3)
    COMPUTE(1)
    if (kt + 2 < nk) LSTORE(ra0, rb0, 0)
    __syncthreads();
  }
#undef GLOAD
#undef LSTORE
#undef COMPUTE
}
DI void zero_acc(f32x16 (&acc)[2][2]) {
#pragma unroll
  for (int a = 0; a < 2; ++a)
#pragma unroll
    for (int b = 0; b < 2; ++b)
#pragma unroll
      for (int i = 0; i < 16; ++i) acc[a][b][i] = 0.f;
}


DI void gemm_kloop4(f32x16 (&acc)[4][2], const u16* __restrict__ A, int lda, const u16* __restrict__ B, int ldb, int K,
                    char* smem) {
  const int tid = ltid(), lane = tid & 63, wid = tid >> 6, wr = wid >> 1, wc = wid & 1;
  const int lr = tid >> 3, lc = tid & 7;
  const int r = lane & 31, h5 = lane >> 5;
  u32x4 ra[8], rb[4];
  const int nk = K >> 6;
  const u16* Ap = A + (size_t)lr * lda + lc * 8;
  const u16* Bp = B + (size_t)lr * ldb + lc * 8;
  const int woff = lr * 128 + ((lc ^ ((lr >> 1) & 7)) << 4);
  const int sw = (r >> 1) & 7;
  const int aoff = (wr * 128 + r) * 128, boff = 32768 + (wc * 64 + r) * 128;
#pragma unroll
  for (int i = 0; i < 8; ++i) ra[i] = *(const u32x4*)(Ap + (size_t)(32 * i) * lda);
#pragma unroll
  for (int i = 0; i < 4; ++i) rb[i] = *(const u32x4*)(Bp + (size_t)(32 * i) * ldb);
  __syncthreads();
#pragma unroll
  for (int i = 0; i < 8; ++i) *(u32x4*)(smem + woff + i * 4096) = ra[i];
#pragma unroll
  for (int i = 0; i < 4; ++i) *(u32x4*)(smem + 32768 + woff + i * 4096) = rb[i];
  __syncthreads();
#pragma unroll 1
  for (int kt = 0; kt < nk; ++kt) {
    if (kt + 1 < nk) {
#pragma unroll
      for (int i = 0; i < 8; ++i) ra[i] = *(const u32x4*)(Ap + (size_t)(32 * i) * lda + (kt + 1) * 64);
#pragma unroll
      for (int i = 0; i < 4; ++i) rb[i] = *(const u32x4*)(Bp + (size_t)(32 * i) * ldb + (kt + 1) * 64);
    }
    __builtin_amdgcn_s_setprio(1);
#pragma unroll
    for (int s = 0; s < 4; ++s) {
      const int ch = ((2 * s + h5) ^ sw) << 4;
      const bf16x8 b0 = *(const bf16x8*)(smem + boff + ch);
      const bf16x8 b1 = *(const bf16x8*)(smem + boff + 4096 + ch);
#pragma unroll
      for (int mt = 0; mt < 4; ++mt) {
        const bf16x8 a = *(const bf16x8*)(smem + aoff + mt * 4096 + ch);
        acc[mt][0] = MFMA32(a, b0, acc[mt][0]);
        acc[mt][1] = MFMA32(a, b1, acc[mt][1]);
      }
    }
    __builtin_amdgcn_s_setprio(0);
    __syncthreads();
    if (kt + 1 < nk) {
#pragma unroll
      for (int i = 0; i < 8; ++i) *(u32x4*)(smem + woff + i * 4096) = ra[i];
#pragma unroll
      for (int i = 0; i < 4; ++i) *(u32x4*)(smem + 32768 + woff + i * 4096) = rb[i];
    }
    __syncthreads();
  }
}
template <int MTW> DI void zero_accT(f32x16 (&acc)[MTW][2]) {
#pragma unroll
  for (int a = 0; a < MTW; ++a)
#pragma unroll
    for (int b = 0; b < 2; ++b)
#pragma unroll
      for (int i = 0; i < 16; ++i) acc[a][b][i] = 0.f;
}
DI void kloopT(f32x16 (&acc)[2][2], const u16* A, int lda, const u16* B, int ldb, int K, char* smem) { gemm_kloop(acc, A, lda, B, ldb, K, smem); }
DI void kloopT(f32x16 (&acc)[4][2], const u16* A, int lda, const u16* B, int ldb, int K, char* smem) { gemm_kloop4(acc, A, lda, B, ldb, K, smem); }

template <int MTW> DI void gemm_in_phase(const Params& p, int l, int bid, int nb, char* smem) {
  const u16* H = (const u16*)(p.ws + OFF_H);
  const u16* Wt = (const u16*)(p.ws + OFF_WT) + WT_IN;
  u16* QK = (u16*)(p.ws + OFF_QK);
  u16* VT = (u16*)(p.ws + OFF_V);
  u16* ZGR = (u16*)(p.ws + OFF_ZGR);
  u16* ZRW = (u16*)(p.ws + OFF_ZRW);
  constexpr int NTN = NIN / 128;
  const int ntiles = (NT / (64 * MTW)) * NTN;
#pragma unroll 1
  for (int t = bid; t < ntiles; t += nb) {
    const int mt_ = t / NTN, nt_ = t % NTN;
    const int row0 = mt_ * (64 * MTW), col0 = nt_ * 128;
    if (l == 1 && row0 >= NL && (col0 < 512 || (col0 >= 2048 && col0 < 3072))) continue;
    f32x16 acc[MTW][2];
    zero_accT<MTW>(acc);
    kloopT(acc, H + (size_t)row0 * 1024, 1024, Wt + (size_t)col0 * 1024, 1024, 1024, smem);
    const int lane = launder(ltid() & 63), wid = launder(ltid() >> 6), wr = wid >> 1, wc = wid & 1;
    const int c = lane & 31, h5 = lane >> 5;
    const int wcol = col0 + wc * 64;
    if (col0 < 1024) {
      const bool isk = col0 >= 512;
      const int head = (wcol & 511) >> 6;
      const float scale = isk ? 0.125f : 1.f;
      const int d1 = (c < 16) ? c : 32 + (c - 16);
      const float inv = exp2f(-(float)(c & 15) * (13.287712379549449f / 16.f));
#pragma unroll
      for (int mt = 0; mt < MTW; ++mt) {
#pragma unroll
        for (int i = 0; i < 16; ++i) {
          const int row = row0 + wr * (32 * MTW) + mt * 32 + crow(i, h5);
          float x1 = acc[mt][0][i], x2 = acc[mt][1][i];
          float o1, o2;
          if (row < NL) {
            const int tt = row & 2047;
            const float pos = (float)((c < 16) ? (tt >> 6) : (tt & 63));
            const float ang = pos * inv;
            const float cs = __cosf(ang), sn = __sinf(ang);
            o1 = x1 * cs - x2 * sn;
            o2 = x1 * sn + x2 * cs;
          } else { o1 = x1; o2 = x2; }
          u16* dst = QK + (size_t)row * 1024 + (isk ? 512 : 0) + head * 64;
          dst[d1] = f2bf(o1 * scale);
          dst[d1 + 16] = f2bf(o2 * scale);
        }
      }
    } else if (col0 < 2048) {
#pragma unroll
      for (int mt = 0; mt < MTW; ++mt)
#pragma unroll
        for (int nt = 0; nt < 2; ++nt) {
          const int n = wcol + nt * 32 + c - 1024;
          const int hh = n >> 7, e = n & 127;
#pragma unroll
          for (int q = 0; q < 4; ++q) {
            const int row = row0 + wr * (32 * MTW) + mt * 32 + 8 * q + 4 * h5;
            int b, tcol;
            if (row < NL) { b = row >> 11; tcol = row & 2047; } else { b = (row - NL) >> 8; tcol = 2048 + ((row - NL) & 255); }
            u32x2 pk = mk2(pack2(acc[mt][nt][4 * q], acc[mt][nt][4 * q + 1]), pack2(acc[mt][nt][4 * q + 2], acc[mt][nt][4 * q + 3]));
            *(u32x2*)(VT + ((size_t)((b * 8 + hh) * 128 + e)) * VT_LD + tcol) = pk;
          }
        }
    } else {
      u16* dstb; int ld, cb;
      if (col0 < 3072) { dstb = ZGR; ld = 1024; cb = wcol - 2048; } else { dstb = ZRW; ld = RWB; cb = wcol - 3072; }
#pragma unroll
      for (int mt = 0; mt < MTW; ++mt)
#pragma unroll
        for (int nt = 0; nt < 2; ++nt)
#pragma unroll
          for (int i = 0; i < 16; ++i) {
            const int row = row0 + wr * (32 * MTW) + mt * 32 + crow(i, h5);
            dstb[(size_t)row * ld + cb + nt * 32 + c] = f2bf(acc[mt][nt][i]);
          }
    }
  }
}

DI void gemm_post2_phase(const Params& p, int mrows, int bid, int nb, char* smem) {
  const u16* SG = (const u16*)(p.ws + OFF_V + (size_t)NT * 512 * 2);
  const u16* Wt = (const u16*)(p.ws + OFF_WT) + WT_G2;
  u16* U = (u16*)(p.ws + OFF_V);
  const int ntiles = (mrows / 128) * 4;
#pragma unroll 1
  for (int t = bid; t < ntiles; t += nb) {
    const int row0 = (t >> 2) * 128, col0 = (t & 3) * 128;
    f32x16 acc[2][2];
    zero_acc(acc);
    gemm_kloop(acc, SG + (size_t)row0 * 128, 128, Wt + (size_t)col0 * 128, 128, 128, smem);
    const int lane = launder(ltid() & 63), wid = launder(ltid() >> 6), wr = wid >> 1, wc = wid & 1;
    const int c = lane & 31, h5 = lane >> 5;
    u16* ub = U + (size_t)(row0 + wr * 64 + 4 * h5) * 512 + col0 + wc * 64 + c;
    u16 oldv[2][2][16];
#pragma unroll
    for (int mt = 0; mt < 2; ++mt)
#pragma unroll
      for (int nt = 0; nt < 2; ++nt)
#pragma unroll
        for (int i = 0; i < 16; ++i) oldv[mt][nt][i] = ub[(size_t)(mt * 32 + (i & 3) + 8 * (i >> 2)) * 512 + nt * 32];
#pragma unroll
    for (int mt = 0; mt < 2; ++mt)
#pragma unroll
      for (int nt = 0; nt < 2; ++nt)
#pragma unroll
        for (int i = 0; i < 16; ++i)
          ub[(size_t)(mt * 32 + (i & 3) + 8 * (i >> 2)) * 512 + nt * 32] = f2bf(bf2f(oldv[mt][nt][i]) * acc[mt][nt][i]);
  }
}

DI void gemm_merge_phase(const Params& p, int mrows, int bid, int nb, char* smem) {
  const u16* H = (const u16*)(p.ws + OFF_H);
  const u16* YRET = (const u16*)(p.ws + OFF_ZGR);
  const u16* YRW = (const u16*)(p.ws + OFF_V);
  const u16* WT = (const u16*)(p.ws + OFF_WT);
  u16* M = (u16*)(p.ws + OFF_QK);
  const int ntiles = (mrows / 128) * 8;
#pragma unroll 1
  for (int t = bid; t < ntiles; t += nb) {
    const int row0 = (t >> 3) * 128, col0 = (t & 7) * 128;
    f32x16 a[2][2];
    unsigned sg[2][2][8];
    zero_acc(a);
    gemm_kloop(a, H + (size_t)row0 * 1024, 1024, WT + WT_IN + (size_t)(NIN + col0) * 1024, 1024, 1024, smem);
#pragma unroll
    for (int mt = 0; mt < 2; ++mt)
#pragma unroll
      for (int nt = 0; nt < 2; ++nt)
#pragma unroll
        for (int i = 0; i < 8; ++i) sg[mt][nt][i] = pack2(sigmoidf_(a[mt][nt][2 * i]), sigmoidf_(a[mt][nt][2 * i + 1]));
    zero_acc(a);
    gemm_kloop(a, YRET + (size_t)row0 * 1024, 1024, WT + WT_A + (size_t)col0 * 1024, 1024, 1024, smem);
    {
      const int lane = launder(ltid() & 63), wid = launder(ltid() >> 6), wr = wid >> 1, wc = wid & 1;
      const int c = lane & 31, h5 = lane >> 5;
      u16* mb = M + (size_t)(row0 + wr * 64 + 4 * h5) * 1024 + col0 + wc * 64 + c;
#pragma unroll
      for (int mt = 0; mt < 2; ++mt)
#pragma unroll
        for (int nt = 0; nt < 2; ++nt)
#pragma unroll
          for (int i = 0; i < 16; ++i) {
            const unsigned ps = sg[mt][nt][i >> 1];
            const float sv = bf2f((u16)((i & 1) ? (ps >> 16) : (ps & 0xffffu)));
            mb[(size_t)(mt * 32 + (i & 3) + 8 * (i >> 2)) * 1024 + nt * 32] = f2bf(sv * a[mt][nt][i]);
          }
    }
    zero_acc(a);
    gemm_kloop(a, H + (size_t)row0 * 1024, 1024, WT + WT_IN + (size_t)(NIN + 1024 + col0) * 1024, 1024, 1024, smem);
#pragma unroll
    for (int mt = 0; mt < 2; ++mt)
#pragma unroll
      for (int nt = 0; nt < 2; ++nt)
#pragma unroll
        for (int i = 0; i < 8; ++i) sg[mt][nt][i] = pack2(sigmoidf_(a[mt][nt][2 * i]), sigmoidf_(a[mt][nt][2 * i + 1]));
    zero_acc(a);
    gemm_kloop(a, YRW + (size_t)row0 * 512, 512, WT + WT_B + (size_t)col0 * 512, 512, 512, smem);
    {
      const int lane = launder(ltid() & 63), wid = launder(ltid() >> 6), wr = wid >> 1, wc = wid & 1;
      const int c = lane & 31, h5 = lane >> 5;
      u16* mb = M + (size_t)(row0 + wr * 64 + 4 * h5) * 1024 + col0 + wc * 64 + c;
      u16 oldv[2][2][16];
#pragma unroll
      for (int mt = 0; mt < 2; ++mt)
#pragma unroll
        for (int nt = 0; nt < 2; ++nt)
#pragma unroll
          for (int i = 0; i < 16; ++i) oldv[mt][nt][i] = mb[(size_t)(mt * 32 + (i & 3) + 8 * (i >> 2)) * 1024 + nt * 32];
#pragma unroll
      for (int mt = 0; mt < 2; ++mt)
#pragma unroll
        for (int nt = 0; nt < 2; ++nt)
#pragma unroll
          for (int i = 0; i < 16; ++i) {
            const unsigned ps = sg[mt][nt][i >> 1];
            const float sv = bf2f((u16)((i & 1) ? (ps >> 16) : (ps & 0xffffu)));
            mb[(size_t)(mt * 32 + (i & 3) + 8 * (i >> 2)) * 1024 + nt * 32] = f2bf(bf2f(oldv[mt][nt][i]) + sv * a[mt][nt][i]);
          }
    }
  }
}

template <int MTW> DI void gemm_out_phase(const Params& p, int l, int mrows, int bid, int nb, char* smem) {
  const u16* M = (const u16*)(p.ws + OFF_QK);
  const u16* WT = (const u16*)(p.ws + OFF_WT) + WT_OUT;
  const int ntiles = (mrows / (64 * MTW)) * 8;
#pragma unroll 1
  for (int t = bid; t < ntiles; t += nb) {
    const int row0 = (t >> 3) * (64 * MTW), col0 = (t & 7) * 128;
    f32x16 acc[MTW][2];
    zero_accT<MTW>(acc);
    kloopT(acc, M + (size_t)row0 * 1024, 1024, WT + (size_t)col0 * 1024, 1024, 1024, smem);
    const int lane = launder(ltid() & 63), wid = launder(ltid() >> 6), wr = wid >> 1, wc = wid & 1;
    const int c = lane & 31, h5 = lane >> 5;
    const float* g1 = mods_ptr(p, l, row_modrow(row0), 2);
    {
      const int rb = row0 + wr * (32 * MTW) + 4 * h5;
      const float* srcb = resid_row(p, l, rb) + col0 + wc * 64 + c;
      float* dstb = ((rb < NL) ? p.out + (size_t)rb * 1024 : (float*)(p.ws + OFF_CTXRES) + (size_t)(rb - NL) * 1024) + col0 + wc * 64 + c;
      const float gv0 = g1[col0 + wc * 64 + c], gv1 = g1[col0 + wc * 64 + 32 + c];
#pragma unroll
      for (int mp = 0; mp < MTW; mp += 2) {
        float oldv[2][2][16];
#pragma unroll
        for (int mt = 0; mt < 2; ++mt)
#pragma unroll
          for (int nt = 0; nt < 2; ++nt)
#pragma unroll
            for (int i = 0; i < 16; ++i) oldv[mt][nt][i] = srcb[(size_t)((mp + mt) * 32 + (i & 3) + 8 * (i >> 2)) * 1024 + nt * 32];
#pragma unroll
        for (int mt = 0; mt < 2; ++mt)
#pragma unroll
          for (int nt = 0; nt < 2; ++nt)
#pragma unroll
            for (int i = 0; i < 16; ++i)
              dstb[(size_t)((mp + mt) * 32 + (i & 3) + 8 * (i >> 2)) * 1024 + nt * 32] = oldv[mt][nt][i] + (nt ? gv1 : gv0) * acc[mp + mt][nt][i];
      }
    }
  }
}

template <int MTW> DI void gemm_ffn1_phase(const Params& p, int mrows, int bid, int nb, char* smem) {
  const u16* H = (const u16*)(p.ws + OFF_H);
  const u16* WT = (const u16*)(p.ws + OFF_WT) + WT_13;
  u16* ACT = (u16*)(p.ws + OFF_V);
  const int ntiles = (mrows / (64 * MTW)) * 44;
#pragma unroll 1
  for (int t = bid; t < ntiles; t += nb) {
    const int row0 = (t / 44) * (64 * MTW), col0 = (t % 44) * 128;
    f32x16 acc[MTW][2];
    zero_accT<MTW>(acc);
    kloopT(acc, H + (size_t)row0 * 1024, 1024, WT + (size_t)col0 * 1024, 1024, 1024, smem);
    const int lane = launder(ltid() & 63), wid = launder(ltid() >> 6), wr = wid >> 1, wc = wid & 1;
    const int c = lane & 31, h5 = lane >> 5;
    const int ocol = ((col0 + wc * 64) >> 6) * 32 + c;
#pragma unroll
    for (int mt = 0; mt < MTW; ++mt)
#pragma unroll
      for (int i = 0; i < 16; ++i) {
        const int row = row0 + wr * (32 * MTW) + mt * 32 + crow(i, h5);
        ACT[(size_t)row * FFN + ocol] = f2bf(siluf_(acc[mt][0][i]) * acc[mt][1][i]);
      }
  }
}
template <int MTW> DI void gemm_ffn2_phase(const Params& p, int l, int mrows, int bid, int nb, char* smem) {
  const u16* ACT = (const u16*)(p.ws + OFF_V);
  const u16* WT = (const u16*)(p.ws + OFF_WT) + WT_2;
  const int ntiles = (mrows / (64 * MTW)) * 8;
#pragma unroll 1
  for (int t = bid; t < ntiles; t += nb) {
    const int row0 = (t >> 3) * (64 * MTW), col0 = (t & 7) * 128;
    f32x16 acc[MTW][2];
    zero_accT<MTW>(acc);
    kloopT(acc, ACT + (size_t)row0 * FFN, FFN, WT + (size_t)col0 * FFN, FFN, FFN, smem);
    const int lane = launder(ltid() & 63), wid = launder(ltid() >> 6), wr = wid >> 1, wc = wid & 1;
    const int c = lane & 31, h5 = lane >> 5;
    const float* g2 = mods_ptr(p, l, row_modrow(row0), 5);
    {
      const int rb = row0 + wr * (32 * MTW) + 4 * h5;
      float* dstb = ((rb < NL) ? p.out + (size_t)rb * 1024 : (float*)(p.ws + OFF_CTXRES) + (size_t)(rb - NL) * 1024) + col0 + wc * 64 + c;
      const float gv0 = g2[col0 + wc * 64 + c], gv1 = g2[col0 + wc * 64 + 32 + c];
#pragma unroll
      for (int mp = 0; mp < MTW; mp += 2) {
        float oldv[2][2][16];
#pragma unroll
        for (int mt = 0; mt < 2; ++mt)
#pragma unroll
          for (int nt = 0; nt < 2; ++nt)
#pragma unroll
            for (int i = 0; i < 16; ++i) oldv[mt][nt][i] = dstb[(size_t)((mp + mt) * 32 + (i & 3) + 8 * (i >> 2)) * 1024 + nt * 32];
#pragma unroll
        for (int mt = 0; mt < 2; ++mt)
#pragma unroll
          for (int nt = 0; nt < 2; ++nt)
#pragma unroll
            for (int i = 0; i < 16; ++i)
              dstb[(size_t)((mp + mt) * 32 + (i & 3) + 8 * (i >> 2)) * 1024 + nt * 32] = oldv[mt][nt][i] + (nt ? gv1 : gv0) * acc[mp + mt][nt][i];
      }
    }
  }
}

DI int chunk_row0(int b, int cidx) { return cidx < 16 ? b * 2048 + cidx * 128 : NL + b * 256 + (cidx - 16) * 128; }

DI void build_kt(char* kt, const u16* __restrict__ QK, int row0, int h, float lg2, bool fwd) {
  const int tid = ltid();
#pragma unroll
  for (int j = 0; j < 4; ++j) {
    const int idx = tid + 256 * j;
    const int m = idx >> 3, dc = idx & 7;
    const u32x4 raw = *(const u32x4*)(QK + (size_t)(row0 + m) * 1024 + 512 + h * 64 + dc * 8);
    const float dec = exp2f(lg2 * (float)(fwd ? (127 - m) : m));

#pragma unroll
    for (int i = 0; i < 8; ++i) {
      const u16 e = (u16)((i & 1) ? (raw[i >> 1] >> 16) : (raw[i >> 1] & 0xffffu));
      const int d = dc * 8 + i;
      *(u16*)(kt + d * 256 + ((((m >> 3) ^ (d & 15)) << 4) | ((m & 7) << 1))) = f2bf(bf2f(e) * dec);
    }
  }
}
DI void state_update(f32x16 (&S)[2], const char* kt, const u16* __restrict__ vt_rows  ,
                     float cd, int lane) {
  const int r = lane & 31, h5 = lane >> 5;
#pragma unroll
  for (int i = 0; i < 16; ++i) { S[0][i] *= cd; S[1][i] *= cd; }
#pragma unroll
  for (int s = 0; s < 8; ++s) {
    const bf16x8 bv = *(const bf16x8*)(vt_rows + (size_t)r * VT_LD + s * 16 + h5 * 8);
    const int ch = 2 * s + h5;
    const bf16x8 a0 = *(const bf16x8*)(kt + r * 256 + ((ch ^ (r & 15)) << 4));
    const bf16x8 a1 = *(const bf16x8*)(kt + (32 + r) * 256 + ((ch ^ (r & 15)) << 4));
    S[0] = MFMA32(a0, bv, S[0]);
    S[1] = MFMA32(a1, bv, S[1]);
  }
}

DI void retention_item(const Params& p, int l, bool ctx_out, int item2, char* smem) {
  const int item = item2;
  const int half = item2 & 3, b = item2 >> 5, h = (item2 >> 2) & 7;
  const int tid = ltid();
  int lane = tid & 63, w = tid >> 6, r = lane & 31, h5 = lane >> 5;
  const u16* QK = (const u16*)(p.ws + OFF_QK);
  const u16* VT = (const u16*)(p.ws + OFF_V) + (size_t)((b * 8 + h) * 128) * VT_LD;
  u16* ZGR = (u16*)(p.ws + OFF_ZGR);
  u16* RS = (l == 0) ? (u16*)p.out + (size_t)item * 5 * 8192 : (u16*)(p.ws + OFF_RS1) + (size_t)item * 4 * 8192;
  char* att = smem;
  char* kt = smem + 32768;
  char* stf = smem + 49152;
  const float LOG2E = 1.4426950408889634f;
  const float lgf2 = -__expf(p.ret_decay[(l * 2 + 0) * 8 + h]) * LOG2E;
  const float lgb2 = -__expf(p.ret_decay[(l * 2 + 1) * 8 + h]) * LOG2E;
  const float cdf = __builtin_amdgcn_exp2f(lgf2 * 128.f), cdb = __builtin_amdgcn_exp2f(lgb2 * 128.f);
  f32x16 S[2];
#pragma unroll
  for (int i = 0; i < 16; ++i) { S[0][i] = 0.f; S[1][i] = 0.f; }
#pragma unroll 1
  for (int it = 0; it < 18; ++it) {
    const int cidx = 17 - it;
    if (cidx < 4 * half) break;
    const int row0 = chunk_row0(b, cidx);
    lane = launder(lane); w = launder(w); r = lane & 31; h5 = lane >> 5;
    if ((cidx < 16) ? ((cidx >> 2) == half) : (ctx_out && (cidx - 16) == half)) {
      u16* img = RS + (size_t)((cidx < 16) ? (cidx & 3) : 4) * 8192;
      const int e = w * 32 + r;
#pragma unroll
      for (int dt = 0; dt < 2; ++dt)
#pragma unroll
        for (int q = 0; q < 4; ++q) {
          const int d = dt * 32 + 8 * q + 4 * h5;
          *(u32x2*)(img + e * 64 + d) = mk2(pack2(S[dt][4 * q], S[dt][4 * q + 1]), pack2(S[dt][4 * q + 2], S[dt][4 * q + 3]));
        }
    }
    __syncthreads();
    build_kt(kt, QK, row0, h, lgb2, false);
    __syncthreads();
    state_update(S, kt, VT + (size_t)(w * 32) * VT_LD + cidx * 128, cdb, lane);
  }
  __syncthreads();
#pragma unroll
  for (int i = 0; i < 16; ++i) { S[0][i] = 0.f; S[1][i] = 0.f; }
#pragma unroll 1
  for (int it = 0; it < 18; ++it) {
    const int cidx = it < 2 ? 16 + it : it - 2;
    if (cidx < 16 && cidx > 4 * half + 3) break;
    const int row0 = chunk_row0(b, cidx);
    lane = launder(lane); w = launder(w); r = lane & 31; h5 = lane >> 5;
    const bool mine = (cidx < 16) ? ((cidx >> 2) == half) : ((cidx - 16) == half);
    const bool outp = mine && ((cidx < 16) || ctx_out);
    __syncthreads();
    {
      const int e = w * 32 + r;
#pragma unroll
      for (int dt = 0; dt < 2; ++dt)
#pragma unroll
        for (int q = 0; q < 4; ++q) {
          const int d = dt * 32 + 8 * q + 4 * h5;
          *(u32x2*)(stf + e * 128 + ((((d >> 3) ^ ((e >> 1) & 7)) << 4) | ((d & 7) << 1))) =
              mk2(pack2(S[dt][4 * q], S[dt][4 * q + 1]), pack2(S[dt][4 * q + 2], S[dt][4 * q + 3]));
        }
    }
    build_kt(kt, QK, row0, h, lgf2, true);
    bf16x8 qf[4];
    if (outp) {
      const int n = w * 32 + r;
#pragma unroll
      for (int s = 0; s < 4; ++s) qf[s] = *(const bf16x8*)(QK + (size_t)(row0 + n) * 1024 + h * 64 + s * 16 + h5 * 8);
#pragma unroll
      for (int mt = 0; mt < 4; ++mt) {
        f32x16 a;
#pragma unroll
        for (int i = 0; i < 16; ++i) a[i] = 0.f;
#pragma unroll
        for (int s = 0; s < 4; ++s) {
          const bf16x8 kf = *(const bf16x8*)(QK + (size_t)(row0 + mt * 32 + r) * 1024 + 512 + h * 64 + s * 16 + h5 * 8);
          a = MFMA32(kf, qf[s], a);
        }
#pragma unroll
        for (int q = 0; q < 4; ++q) {
          float o[4];
#pragma unroll
          for (int j = 0; j < 4; ++j) {
            const int m = mt * 32 + 8 * q + 4 * h5 + j;
            const float dd = (m <= n) ? __builtin_amdgcn_exp2f(lgf2 * (float)(n - m)) : __builtin_amdgcn_exp2f(lgb2 * (float)(m - n));
            o[j] = a[4 * q + j] * dd;
          }
          const int m0 = mt * 32 + 8 * q + 4 * h5;
          *(u32x2*)(att + n * 256 + ((((m0 >> 3) ^ (n & 15)) << 4) | ((m0 & 7) << 1))) = mk2(pack2(o[0], o[1]), pack2(o[2], o[3]));
        }
      }
    }
    __syncthreads();
    if (outp) {
      const int n = w * 32 + r;
      f32x16 y[4];
#pragma unroll
      for (int et = 0; et < 4; ++et) {
        f32x16 a;
#pragma unroll
        for (int i = 0; i < 16; ++i) a[i] = 0.f;
        const int e = et * 32 + r;
#pragma unroll
        for (int s = 0; s < 4; ++s) {
          const bf16x8 bs = *(const bf16x8*)(stf + e * 128 + (((2 * s + h5) ^ ((e >> 1) & 7)) << 4));
          a = MFMA32(qf[s], bs, a);
        }
#pragma unroll
        for (int i = 0; i < 16; ++i) {
          const int nn = w * 32 + crow(i, h5);
          y[et][i] = a[i] * __builtin_amdgcn_exp2f(lgf2 * (float)(nn + 1));
        }
        __builtin_amdgcn_sched_barrier(0);
      }
      {
        const u16* img = RS + (size_t)((cidx < 16) ? (cidx & 3) : 4) * 8192;
#pragma unroll
        for (int et = 0; et < 4; ++et) {
          f32x16 a;
#pragma unroll
          for (int i = 0; i < 16; ++i) a[i] = 0.f;
          const int e = et * 32 + r;
#pragma unroll
          for (int s = 0; s < 4; ++s) {
            const bf16x8 bs = *(const bf16x8*)(img + e * 64 + s * 16 + h5 * 8);
            a = MFMA32(qf[s], bs, a);
          }
#pragma unroll
          for (int i = 0; i < 16; ++i) {
            const int nn = w * 32 + crow(i, h5);
            y[et][i] += a[i] * __builtin_amdgcn_exp2f(lgb2 * (float)(128 - nn));
          }
          __builtin_amdgcn_sched_barrier(0);
        }
      }
#pragma unroll 2
      for (int s = 0; s < 8; ++s) {
        const bf16x8 af = *(const bf16x8*)(att + n * 256 + (((2 * s + h5) ^ (n & 15)) << 4));
#pragma unroll
        for (int et = 0; et < 4; ++et) {
          const bf16x8 bv = *(const bf16x8*)(VT + (size_t)(et * 32 + r) * VT_LD + cidx * 128 + s * 16 + h5 * 8);
          y[et] = MFMA32(af, bv, y[et]);
        }
      }
      const float* gn = p.ret_norm_g + l * 1024 + h * 128;
      float gam[4];
#pragma unroll
      for (int et = 0; et < 4; ++et) gam[et] = gn[et * 32 + r];
#pragma unroll
      for (int i = 0; i < 16; ++i) {
        float s1 = y[0][i] + y[1][i] + y[2][i] + y[3][i];
        float s2 = y[0][i] * y[0][i] + y[1][i] * y[1][i] + y[2][i] * y[2][i] + y[3][i] * y[3][i];
#pragma unroll
        for (int m = 16; m >= 1; m >>= 1) { s1 += __shfl_xor(s1, m, 64); s2 += __shfl_xor(s2, m, 64); }
        const float mu = s1 * (1.f / 128.f);
        const float var = fmaxf(s2 * (1.f / 128.f) - mu * mu, 0.f);
        const float rs = rsqrtf(var + 1e-5f);
        const int row = row0 + w * 32 + crow(i, h5);
        u16* zp = ZGR + (size_t)row * 1024 + h * 128 + r;
#pragma unroll
        for (int et = 0; et < 4; ++et) y[et][i] = (y[et][i] - mu) * rs * gam[et];
        (void)zp;
      }
      {
        u16* zb = ZGR + (size_t)(row0 + w * 32 + 4 * h5) * 1024 + h * 128 + r;
#pragma unroll
        for (int half = 0; half < 2; ++half) {
          u16 zv[4][8];
#pragma unroll
          for (int et = 0; et < 4; ++et)
#pragma unroll
            for (int ii = 0; ii < 8; ++ii) {
              const int i = half * 8 + ii;
              zv[et][ii] = zb[(size_t)((i & 3) + 8 * (i >> 2)) * 1024 + et * 32];
            }
#pragma unroll
          for (int et = 0; et < 4; ++et)
#pragma unroll
            for (int ii = 0; ii < 8; ++ii) {
              const int i = half * 8 + ii;
              zb[(size_t)((i & 3) + 8 * (i >> 2)) * 1024 + et * 32] = f2bf(y[et][i] * siluf_(bf2f(zv[et][ii])));
            }
        }
      }
    }
    state_update(S, kt, VT + (size_t)(w * 32) * VT_LD + cidx * 128, cdf, lane);
  }
  __syncthreads();
}

DI int shift_nbr(int row, int col) {
  if (row < NL) {
    const int t = row & 2047, tc = t & 63, tr = t >> 6;
    switch (col & 3) {
      case 0: return tc > 0 ? row - 1 : -1;
      case 1: return tc < 63 ? row + 1 : -1;
      case 2: return tr > 0 ? row - 64 : -1;
      default: return tr < 31 ? row + 64 : -1;
    }
  } else {
    const int t = (row - NL) & 255;
    if ((col & 1) == 0) return t > 0 ? row - 1 : -1;
    return t < 255 ? row + 1 : -1;
  }
}
DI float zshift(const u16* __restrict__ Z, int row, int nrow, int col, float mu) {
  const float v = bf2f(Z[(size_t)row * RWB + col]);
  const float nv = nrow >= 0 ? bf2f(Z[(size_t)nrow * RWB + col]) : 0.f;
  return v + mu * (nv - v);
}

constexpr int TC = 16;
typedef __attribute__((ext_vector_type(4))) float f32x4_t;
#define MFMA16(a, b, c) __builtin_amdgcn_mfma_f32_16x16x32_bf16((a), (b), (c), 0, 0, 0)
DI void scan_item(const Params& p, int l, bool ctx_out, int item, char* smem) {
  const int dir = item & 1, h = (item >> 1) & 7, b = item >> 4;
  const int tid = ltid(), lane = tid & 63, w = tid >> 6;
  const int c = lane, tg = w;
  const int kg = lane & 15, rg = lane >> 4;
  const u16* __restrict__ Z = (const u16*)(p.ws + OFF_ZRW);
  u16* YD = (u16*)(p.ws + OFF_QK) + (size_t)dir * NT * 512;
  float* BON = (float*)(p.ws + OFF_BONUS) + (size_t)dir * NT * 8;
  float* zs = (float*)smem;
  float* ops = zs + TC * 3 * 64;
  u16* zwb = (u16*)(ops + TC * 4 * 64);
  u16* zab = zwb + 16 * 72;
  const int hc = h * 64 + c;
  const int cl = lane & 15, q4 = lane >> 4;
  bf16x8 bw[2], ba[2];
  {
    const float* w2 = p.rwkv_w2 + (size_t)(l * 2 + dir) * 64 * 512 + h * 64 + 16 * w + cl;
    const float* a2 = p.rwkv_a2 + (size_t)(l * 2 + dir) * 64 * 512 + h * 64 + 16 * w + cl;
#pragma unroll
    for (int s = 0; s < 2; ++s)
#pragma unroll
      for (int jj = 0; jj < 8; ++jj) {
        const int j = s * 32 + q4 * 8 + jj;
        bw[s][jj] = (short)f2bf(w2[j * 512]);
        ba[s][jj] = (short)f2bf(a2[j * 512]);
      }
  }
  const int hc2 = h * 64 + 16 * w + cl;
  const float w0c = p.rwkv_w0[(l * 2 + dir) * 512 + hc2], a0c = p.rwkv_a0[(l * 2 + dir) * 512 + hc2];
  const float kac = p.rwkv_k_a[l * 512 + hc2];
  const float kkc = p.rwkv_k_k[l * 512 + hc];
  f32x4 rk4;
#pragma unroll
  for (int j = 0; j < 4; ++j) rk4[j] = 0.5f * p.rwkv_r_k[l * 512 + h * 64 + 4 * kg + j];
  const int gcol[5] = {hc, 512 + hc, 1024 + hc, 1536 + 64 * dir + c, 1664 + 64 * dir + c};
  float muv[5];
#pragma unroll
  for (int g = 0; g < 5; ++g) muv[g] = p.rwkv_mu[l * RWB + gcol[g]];
  float S[4][4];
#pragma unroll
  for (int a = 0; a < 4; ++a)
#pragma unroll
    for (int j = 0; j < 4; ++j) S[a][j] = 0.f;
  __syncthreads();
  u16 raw[4][5][2];
  const int NCH = 256 / TC + 2048 / TC;
#define CHUNK_INFO(ci, n_, rbase_, c0_) \
  const int n_ = (ci) < 256 / TC ? 256 : 2048; \
  const int rbase_ = (ci) < 256 / TC ? NL + b * 256 : b * 2048; \
  const int c0_ = (ci) < 256 / TC ? (ci) * TC : ((ci) - 256 / TC) * TC;
#define ISSUE_LOADS(ci) { \
    CHUNK_INFO(ci, n__, rb__, c0__) \
    _Pragma("unroll") for (int q = 0; q < 4; ++q) { \
      const int sidx = c0__ + tg * 4 + q; \
      const int row = rb__ + (dir == 0 ? sidx : n__ - 1 - sidx); \
      const int nrow = shift_nbr(row, c); \
      _Pragma("unroll") for (int g = 0; g < 5; ++g) { \
        raw[q][g][0] = Z[(size_t)row * RWB + gcol[g]]; \
        raw[q][g][1] = nrow >= 0 ? Z[(size_t)nrow * RWB + gcol[g]] : (u16)0; \
      } \
    } }
  ISSUE_LOADS(0)
#pragma unroll 1
  for (int ci = 0; ci < NCH; ++ci) {
    CHUNK_INFO(ci, n, rbase, c0)
    const bool emit = (ci >= 256 / TC) || ctx_out;
#pragma unroll
    for (int q = 0; q < 4; ++q) {
      const int i = tg * 4 + q;
      float zv[5];
#pragma unroll
      for (int g = 0; g < 5; ++g) {
        const float v0 = bf2f(raw[q][g][0]), v1 = bf2f(raw[q][g][1]);
        zv[g] = v0 + muv[g] * (v1 - v0);
      }
      zs[(i * 3 + 0) * 64 + c] = zv[0];
      zs[(i * 3 + 1) * 64 + c] = zv[1];
      zs[(i * 3 + 2) * 64 + c] = zv[2];
      zwb[i * 72 + c] = f2bf(tanhf_(zv[3]));
      zab[i * 72 + c] = f2bf(zv[4]);
      const float kkr = zv[1] * kkc;
      const float ss = wave_sum_dpp(kkr * kkr);
      ops[(i * 4 + 1) * 64 + c] = kkr * rsqrtf(ss + 1e-12f);
    }
    __syncthreads();
    {
      f32x4_t accw = {0.f, 0.f, 0.f, 0.f}, acca = {0.f, 0.f, 0.f, 0.f};
#pragma unroll
      for (int s = 0; s < 2; ++s) {
        const bf16x8 aw = *(const bf16x8*)(zwb + cl * 72 + s * 32 + q4 * 8);
        const bf16x8 aa = *(const bf16x8*)(zab + cl * 72 + s * 32 + q4 * 8);
        accw = MFMA16(aw, bw[s], accw);
        acca = MFMA16(aa, ba[s], acca);
      }
      const int ch = 16 * w + cl;
#pragma unroll
      for (int rr = 0; rr < 4; ++rr) {
        const int i = 4 * q4 + rr;
        const float wl = accw[rr] + w0c, al = acca[rr] + a0c;
        const float sp = __logf(1.f + __expf(-wl));
        const float dec = __expf(-__expf(-sp - 0.5f));
        const float av = sigmoidf_(al);
        const float zk = zs[(i * 3 + 1) * 64 + ch];
        const float kkn = ops[(i * 4 + 1) * 64 + ch];
        ops[(i * 4 + 0) * 64 + ch] = dec;
        ops[(i * 4 + 2) * 64 + ch] = kkn * av;
        ops[(i * 4 + 3) * 64 + ch] = zk * (1.f + (av - 1.f) * kac);
      }
    }
    if (ci + 1 < NCH) ISSUE_LOADS(ci + 1)
    __syncthreads();
    f32x4 nw4 = *(const f32x4*)(ops + 0 * 64 + 4 * kg);
    f32x4 nkk4 = *(const f32x4*)(ops + 1 * 64 + 4 * kg);
    f32x4 nb4 = *(const f32x4*)(ops + 2 * 64 + 4 * kg);
    f32x4 nk4 = *(const f32x4*)(ops + 3 * 64 + 4 * kg);
    f32x4 nr4 = *(const f32x4*)(zs + 0 * 64 + 4 * kg);
    f32x4 nv4 = *(const f32x4*)(zs + 2 * 64 + 16 * w + 4 * rg);
#pragma unroll 2
    for (int i = 0; i < TC; ++i) {
      const f32x4 w4 = nw4, kk4 = nkk4, b4 = nb4, k4 = nk4, r4 = nr4, v4 = nv4;
      if (i + 1 < TC) {
        const int i1 = i + 1;
        nw4 = *(const f32x4*)(ops + (i1 * 4 + 0) * 64 + 4 * kg);
        nkk4 = *(const f32x4*)(ops + (i1 * 4 + 1) * 64 + 4 * kg);
        nb4 = *(const f32x4*)(ops + (i1 * 4 + 2) * 64 + 4 * kg);
        nk4 = *(const f32x4*)(ops + (i1 * 4 + 3) * 64 + 4 * kg);
        nr4 = *(const f32x4*)(zs + (i1 * 3 + 0) * 64 + 4 * kg);
        nv4 = *(const f32x4*)(zs + (i1 * 3 + 2) * 64 + 16 * w + 4 * rg);
      }
      float sk[4], y[4];
#pragma unroll
      for (int a = 0; a < 4; ++a) {
        sk[a] = S[a][0] * kk4[0] + S[a][1] * kk4[1] + S[a][2] * kk4[2] + S[a][3] * kk4[3];
        if (dir == 1) y[a] = S[a][0] * r4[0] + S[a][1] * r4[1] + S[a][2] * r4[2] + S[a][3] * r4[3];
      }
#pragma unroll
      for (int a = 0; a < 4; ++a) sk[a] = allred16(sk[a]);
#pragma unroll
      for (int a = 0; a < 4; ++a)
#pragma unroll
        for (int j = 0; j < 4; ++j) S[a][j] = S[a][j] * w4[j] + (v4[a] * k4[j] - sk[a] * b4[j]);
      if (dir == 0) {
#pragma unroll
        for (int a = 0; a < 4; ++a) y[a] = S[a][0] * r4[0] + S[a][1] * r4[1] + S[a][2] * r4[2] + S[a][3] * r4[3];
      }
      if (emit) {
        float bo = r4[0] * k4[0] * rk4[0] + r4[1] * k4[1] * rk4[1] + r4[2] * k4[2] * rk4[2] + r4[3] * k4[3] * rk4[3];
        bo = allred16(bo);
#pragma unroll
        for (int a = 0; a < 4; ++a) y[a] = allred16(y[a]);
        if (kg == 0) {
          const int sidx = c0 + i;
          const int row = rbase + (dir == 0 ? sidx : n - 1 - sidx);
          *(u32x2*)(YD + (size_t)row * 512 + h * 64 + 16 * w + 4 * rg) = mk2(pack2(y[0], y[1]), pack2(y[2], y[3]));
          if (tid == 0) BON[(size_t)row * 8 + h] = bo;
        }
      }
    }
    __syncthreads();
  }
#undef ISSUE_LOADS
#undef CHUNK_INFO
}

DI void post1_rows(const Params& p, int l, int nrows, int bid, int nb) {
  const int lane = ltid() & 63, wid = ltid() >> 6;
  const int nw = nb * 4;
  const u16* __restrict__ Z = (const u16*)(p.ws + OFF_ZRW);
  const u16* __restrict__ YF = (const u16*)(p.ws + OFF_QK);
  const u16* __restrict__ YB = YF + (size_t)NT * 512;
  const float* __restrict__ BF = (const float*)(p.ws + OFF_BONUS);
  const float* __restrict__ BB = BF + (size_t)NT * 8;
  u16* __restrict__ U = (u16*)(p.ws + OFF_V);
  u16* __restrict__ SG = U + (size_t)NT * 512;
  const float* __restrict__ mu = p.rwkv_mu + l * RWB;
  const float* __restrict__ ng = p.rwkv_norm_g + l * 512;
  for (int row = bid * 4 + wid; row < nrows; row += nw) {
    const int nrow = shift_nbr(row, lane);
    float yv[8], vsv[8], bonv[8];
#pragma unroll
    for (int hh = 0; hh < 8; ++hh) {
      const int col = hh * 64 + lane;
      yv[hh] = bf2f(YF[(size_t)row * 512 + col]) + bf2f(YB[(size_t)row * 512 + col]);
      bonv[hh] = BF[(size_t)row * 8 + hh] + BB[(size_t)row * 8 + hh];
      vsv[hh] = zshift(Z, row, nrow, 1024 + col, mu[1024 + col]);
    }
#pragma unroll
    for (int hh = 0; hh < 8; ++hh) {
      const int col = hh * 64 + lane;
      const float y = yv[hh];
      const float mean = wave_sum_dpp(y) * (1.f / 64.f);
      const float d = y - mean;
      const float var = wave_sum_dpp(d * d) * (1.f / 64.f);
      float o = d * rsqrtf(var + 64e-5f) * ng[col];
      o += bonv[hh] * vsv[hh];
      U[(size_t)row * 512 + col] = f2bf(o);
    }
#pragma unroll
    for (int jj = 0; jj < 2; ++jj) {
      const int col = 1792 + jj * 64 + lane;
      const float zg = zshift(Z, row, nrow, col, mu[col]);
      SG[(size_t)row * 128 + jj * 64 + lane] = f2bf(sigmoidf_(zg));
    }
  }
}

constexpr int NPHASE = 1 + 11 * 2 + 1;

DI void run_phase(const Params& p, int ph, int bid, int nb, char* smem) {
  if (ph == 0) {
    if (nb >= 384) {
      if (bid < 192) mods_item(p, bid, smem);
      else for (int it = bid - 192; it < WC_TOTAL; it += nb - 192) wconv_item(p, 0, it, smem);
    } else {
      for (int it = bid; it < 192 + WC_TOTAL; it += nb) {
        if (it < 192) mods_item(p, it, smem); else wconv_item(p, 0, it - 192, smem);
      }
    }
    return;
  }
  if (ph == NPHASE - 1) { final_norm(p, bid, nb); return; }
  const int l = (ph - 1) / 11, s = (ph - 1) % 11;
  const bool ctx_out = (l == 0);
  const int mrows = ctx_out ? NT : NL;
  switch (s) {
    case 0:
      norm_rows(p, l, 0, NT, bid, nb);
      if (l > 0) for (int it = bid; it < WC_TOTAL; it += nb) wconv_item(p, l, it, smem);
      break;
    case 1: gemm_in_phase<4>(p, l, bid, nb, smem); break;
    case 2: for (int it = bid; it < 512; it += nb) retention_item(p, l, ctx_out, it, smem); break;
    case 3: for (int it = bid; it < 256; it += nb) scan_item(p, l, ctx_out, it, smem); break;
    case 4: post1_rows(p, l, mrows, bid, nb); break;
    case 5: gemm_post2_phase(p, mrows, bid, nb, smem); break;
    case 6: gemm_merge_phase(p, mrows, bid, nb, smem); break;
    case 7: if (l == 0) gemm_out_phase<2>(p, l, mrows, bid, nb, smem); else gemm_out_phase<4>(p, l, mrows, bid, nb, smem); break;
    case 8: norm_rows(p, l, 1, mrows, bid, nb); break;
    case 9: gemm_ffn1_phase<4>(p, mrows, bid, nb, smem); break;
    case 10: if (l == 0) gemm_ffn2_phase<2>(p, l, mrows, bid, nb, smem); else gemm_ffn2_phase<4>(p, l, mrows, bid, nb, smem); break;
  }
}


#define XB_TMO      128
#define XB_XCNT(j)  (256  + 64 * (j))
#define XB_XSUB(j)  (1280 + 64 * (j))
#define XB_XGEN(j)  (2304 + 64 * (j))
#define XB_TOP      3328
#define XB_TOPGEN   3392
#define XCD_BAR_WORDS 3456
#define XB_SPIN_CAP (1u << 22)
#define LAS __attribute__((address_space(3)))
DI unsigned xb_ld(unsigned* p) { return __hip_atomic_load(p, __ATOMIC_RELAXED, __HIP_MEMORY_SCOPE_AGENT); }
DI unsigned xb_add(unsigned* p, unsigned v) { return __hip_atomic_fetch_add(p, v, __ATOMIC_RELAXED, __HIP_MEMORY_SCOPE_AGENT); }
DI unsigned xb_xcc_id() { return (unsigned)__builtin_amdgcn_s_getreg((3 << 11) | 20) & 0xFu; }
#define XB_SPIN(cond, bar) do { unsigned _sp = 0; while (cond) { __builtin_amdgcn_s_sleep(1); \
    if ((++_sp & 255u) == 0u) { if (xb_ld(&(bar)[XB_TMO])) break; if (_sp > XB_SPIN_CAP) { atomicAdd(&(bar)[XB_TMO], 1u); break; } } } } while (0)
struct XcdBarrier { unsigned* bar; unsigned x; volatile LAS unsigned* st; };
DI XcdBarrier xcd_barrier_post(unsigned* bar, volatile LAS unsigned* st) {
  XcdBarrier b; b.bar = bar; b.x = xb_xcc_id(); b.st = st;
  if (threadIdx_raw() == 0) (void)xb_add(&bar[XB_XCNT(b.x)], 1u);
  return b;
}
DI void xcd_barrier_complete(unsigned* bar, unsigned x, unsigned& nloc, unsigned& nx) {
  const unsigned G = gridDim.x * gridDim.y * gridDim.z;
  unsigned sum, cnt, mine, sp = 0u;
  for (;;) {
    sum = 0u; cnt = 0u; mine = 0u;
#pragma unroll
    for (unsigned j = 0; j < 16; ++j) { const unsigned c = xb_ld(&bar[XB_XCNT(j)]); sum += c; cnt += (c > 0u) ? 1u : 0u; mine = (j == x) ? c : mine; }
    if (sum == G) break;
    __builtin_amdgcn_s_sleep(1);
    if ((++sp & 255u) == 0u) { if (xb_ld(&bar[XB_TMO])) break; if (sp > XB_SPIN_CAP) { atomicAdd(&bar[XB_TMO], 1u); break; } }
  }
  nloc = mine > 0u ? mine : 1u; nx = cnt > 0u ? cnt : 1u;
}
DI void xcd_barrier(const XcdBarrier& b) {
  asm volatile("s_waitcnt vmcnt(0)" ::: "memory");
  __syncthreads();
  if (threadIdx_raw() == 0) {
    unsigned* bar = b.bar;
    __builtin_amdgcn_s_waitcnt(0);
    unsigned nloc = b.st[0], nx = b.st[1];
    if (nloc == 0u) { xcd_barrier_complete(bar, b.x, nloc, nx); b.st[0] = nloc; b.st[1] = nx; }
    const unsigned old = xb_add(&bar[XB_XSUB(b.x)], 1u);
    const unsigned gen = old / nloc;
    if (old + 1u == (gen + 1u) * nloc) {
      __builtin_amdgcn_fence(__ATOMIC_RELEASE, "agent");
      asm volatile("s_waitcnt vmcnt(0)" ::: "memory");
      const unsigned og = xb_add(&bar[XB_TOP], 1u);
      const unsigned tg = og / nx;
      if (og + 1u == (tg + 1u) * nx) xb_add(&bar[XB_TOPGEN], 1u);
      else XB_SPIN(xb_ld(&bar[XB_TOPGEN]) == tg, bar);
      __builtin_amdgcn_fence(__ATOMIC_ACQUIRE, "agent");
      xb_add(&bar[XB_XGEN(b.x)], 1u);
      asm volatile("s_waitcnt vmcnt(0)" ::: "memory");
    } else {
      XB_SPIN(xb_ld(&bar[XB_XGEN(b.x)]) == gen, bar);
      __builtin_amdgcn_fence(__ATOMIC_ACQUIRE, "agent");
      asm volatile("s_waitcnt vmcnt(0)" ::: "memory");
    }
  }
  __syncthreads();
}

#if MEGA
__global__ void __launch_bounds__(256, 2) mega_kernel(Params p) {
  __shared__ __attribute__((aligned(16))) char smem[SMEM_BYTES];
  cg::grid_group grid = cg::this_grid();
  __shared__ int s_vbid;
  __shared__ u32x4 xb_words;
  if (threadIdx_raw() == 0) { u32x4 z = {0u, 0u, 0u, 0u}; xb_words = z; }
  __syncthreads();
  XcdBarrier xb = xcd_barrier_post((unsigned*)(p.ws + OFF_BAR), (volatile LAS unsigned*)&xb_words);
  if (threadIdx.x == 0) {
    int* tab = (int*)(p.ws + OFF_TAB);
    const unsigned xcc = (unsigned)__builtin_amdgcn_s_getreg(20 | (3 << 11)) & 0xfu;
    const unsigned cuk = ((unsigned)__builtin_amdgcn_s_getreg(63492) >> 8) & 0xffu;
    const int rank = atomicAdd(&tab[(xcc & 7) * 256 + cuk], 1);
    int v;
    if (rank == 0) v = atomicAdd(&tab[2048], 1);
    else v = (int)gridDim.x - 1 - atomicAdd(&tab[2049], 1);
    s_vbid = v;
  }
  __syncthreads();
  const int vbid = s_vbid;
#pragma unroll 1
  for (int ph = 0; ph < NPHASE; ++ph) {
    Params q = p;
    {
      size_t zoff = 0;
      asm volatile("" : "+s"(zoff));
      q.ws = p.ws + zoff;
      q.out = p.out + zoff;
    }
    run_phase(q, ph, vbid, gridDim.x, smem);
    if (ph + 1 < NPHASE) {
      if (ph == 0) grid.sync();
      else xcd_barrier(xb);
    }
  }
}
#else
__global__ void __launch_bounds__(256, 2) phase_kernel(Params p, int ph) {
  __shared__ __attribute__((aligned(16))) char smem[SMEM_BYTES];
  run_phase(p, ph, blockIdx.x, gridDim.x, smem);
}
#endif

extern "C" void kernel_launch(void* const* d_in, const int* in_sizes, int n_in, void* d_out, int out_size, void* d_ws,
                              size_t ws_size, hipStream_t stream) {
  if (ws_size < WS_NEED) { fprintf(stderr, "workspace too small: %zu < %zu\n", ws_size, (size_t)WS_NEED); return; }
  Params p{};
  const float** fp = (const float**)&p;
  for (int i = 0; i < 27; ++i) fp[i] = (const float*)d_in[i];
  p.out = (float*)d_out;
  p.ws = (char*)d_ws;
#if MEGA
  static int grid_blocks = 0;
  if (!grid_blocks) {
    int dev = 0, cus = 0, per_cu = 0;
    hipGetDevice(&dev);
    hipDeviceGetAttribute(&cus, hipDeviceAttributeMultiprocessorCount, dev);
    hipOccupancyMaxActiveBlocksPerMultiprocessor(&per_cu, mega_kernel, 256, 0);
    if (per_cu > 2) per_cu = 2;
    if (per_cu < 2) { fprintf(stderr, "occupancy query says %d per CU; forcing 2\n", per_cu); per_cu = 2; }
    grid_blocks = cus * per_cu;
  }
  hipMemsetAsync((char*)d_ws + OFF_TAB, 0, TAB_BYTES, stream);
  void* args[] = {&p};
  hipError_t e = hipLaunchCooperativeKernel((void*)mega_kernel, dim3(grid_blocks), dim3(256), args, 0, stream);
  if (e != hipSuccess) fprintf(stderr, "cooperative launch failed: %s (grid %d)\n", hipGetErrorString(e), grid_blocks);
#else
  for (int ph = 0; ph < NPHASE; ++ph) phase_kernel<<<512, 256, 0, stream>>>(p, ph);
#endif
}
```
